# Optimizing an MI355X kernel written in HIP

```python
import math
import jax, jax.numpy as jnp
from jax import lax
import numpy as np

D_MODEL = 1024
BATCH = 8
SEQ = 2048
DEPTH = 2
DEC_BATCH = 128
DEC_SEQ = 1
PAST_LEN = 16384
PAGE_SIZE = 128

HEAD_A = 64
N_HEADS_A = 8
D_A = N_HEADS_A * HEAD_A
D_DECAY_LORA = 64
D_ICLR_LORA = 64
D_VRES_LORA = 32
GN_EPS = 64e-5
CHUNK = 128
N_GROUPS_B = 4
D_B = D_MODEL // 2
GROUP_B = D_B // N_GROUPS_B
D_PLE = 256
EPS = 1e-6
N_SHIFT = 3 * D_A + D_DECAY_LORA + D_ICLR_LORA
D_IN = N_SHIFT + D_A + 2 * D_B + D_B + 2 * D_MODEL

kernel_name = "rwkv7_gmlp_gated_hybrid_step"


def _rms_norm(x, g):
    xf = x.astype(jnp.float32)
    y = xf * lax.rsqrt(jnp.mean(xf * xf, axis=-1, keepdims=True) + EPS)
    return (y * g.astype(jnp.float32)).astype(x.dtype)


def _layer_norm(x, g, b):
    xf = x.astype(jnp.float32)
    mu = jnp.mean(xf, axis=-1, keepdims=True)
    var = jnp.mean((xf - mu) ** 2, axis=-1, keepdims=True)
    y = (xf - mu) * lax.rsqrt(var + 1e-5)
    return (y * g.astype(jnp.float32) + b.astype(jnp.float32)).astype(x.dtype)


def _wkv_step(S, inp):
    r, w, k, v, aa, bb = inp
    sa = jnp.einsum('bhij,bhj->bhi', S, aa)
    S = S * w[:, :, None, :] + sa[..., :, None] * bb[..., None, :] + v[..., :, None] * k[..., None, :]
    y = jnp.einsum('bhij,bhj->bhi', S, r)
    return S, y


def _rwkv7(z, shift_prev, xn, v_first, wkv0, mu, w0, w_up, a0, a_up, k_k, k_a, r_k, gn_g, gn_b, vres):
    B, T, _ = z.shape
    z_prev = jnp.concatenate([shift_prev[:, None, :].astype(z.dtype), z[:, :-1]], axis=1)
    zs = z + (z_prev - z) * mu
    r = zs[..., :D_A]
    k = zs[..., D_A:2 * D_A]
    v = zs[..., 2 * D_A:3 * D_A]
    wd = zs[..., 3 * D_A:3 * D_A + D_DECAY_LORA]
    ad = zs[..., 3 * D_A + D_DECAY_LORA:]
    w = -jax.nn.softplus(-(w0 + jnp.tanh(wd) @ w_up)) - 0.5
    decay = jnp.exp(-jnp.exp(w.astype(jnp.float32)))
    a = jax.nn.sigmoid(a0 + ad @ a_up)
    if vres is not None:
        vd, vu, vb = vres
        v = v + (v_first - v) * jax.nn.sigmoid(vb + (xn @ vd) @ vu)
    heads = lambda t: t.reshape(B, T, N_HEADS_A, HEAD_A).astype(jnp.float32)
    kk = heads(k * k_k)
    kk = kk / jnp.maximum(jnp.sqrt(jnp.sum(kk * kk, axis=-1, keepdims=True)), 1e-12)
    k = k * (1.0 + (a - 1.0) * k_a)
    rh, kh, vh, ah = heads(r), heads(k), heads(v), heads(a)
    wh = decay.reshape(B, T, N_HEADS_A, HEAD_A)
    aa = -kk
    bb = kk * ah
    tm = lambda t: jnp.moveaxis(t, 1, 0)
    S, y = lax.scan(_wkv_step, wkv0.astype(jnp.float32),
                    (tm(rh), tm(wh), tm(kh), tm(vh), tm(aa), tm(bb)))
    y = jnp.moveaxis(y, 0, 1)
    m = jnp.mean(y, axis=-1, keepdims=True)
    var = jnp.mean((y - m) ** 2, axis=-1, keepdims=True)
    y = ((y - m) * lax.rsqrt(var + GN_EPS)).reshape(B, T, D_A)
    y = y * gn_g.astype(jnp.float32) + gn_b.astype(jnp.float32)
    bonus = jnp.sum(rh * kh * r_k.astype(jnp.float32), axis=-1, keepdims=True) * vh
    y = y + bonus.reshape(B, T, D_A)
    return y.astype(z.dtype), S, z[:, -1], v


def _chunk_spatial(v_n, w_s, b_s):
    B, T, _ = v_n.shape
    n_chunks = -(-T // CHUNK)
    pad = n_chunks * CHUNK - T
    vp = jnp.pad(v_n, ((0, 0), (0, pad), (0, 0))).reshape(B, n_chunks, CHUNK, N_GROUPS_B, GROUP_B)
    mask = jnp.tril(jnp.ones((CHUNK, CHUNK), dtype=bool))
    wm = jnp.where(mask[None], w_s, jnp.zeros_like(w_s))
    mixed = jnp.einsum('gts,bnsgc->bntgc', wm, vp) + jnp.swapaxes(b_s, 0, 1)[None, None, :, :, None]
    return mixed.reshape(B, n_chunks * CHUNK, D_B)[:, :T]


def _forward(x, p, wkv0, shift0, W):
    h = x
    v_first = None
    wkvs, shifts, chunk_vs = [], [], []
    for l in range(DEPTH):
        xn = _rms_norm(h, W['norm_g'][l])
        zall = jnp.einsum('btd,de->bte', xn, W['w_in'][l])
        o = N_SHIFT
        z_shift = zall[..., :o]
        g_a = zall[..., o:o + D_A]; o += D_A
        u = jax.nn.gelu(zall[..., o:o + D_B]); o += D_B
        vb_ = jax.nn.gelu(zall[..., o:o + D_B]); o += D_B
        g_b = zall[..., o:o + D_B]; o += D_B
        m_a = zall[..., o:o + D_MODEL]; o += D_MODEL
        m_b = zall[..., o:o + D_MODEL]
        vres = None if l == 0 else (W['vres_down'][l - 1], W['vres_up'][l - 1], W['vres_b'][l - 1])
        y_a, S, last, v = _rwkv7(z_shift, shift0[l], xn, v_first, wkv0[l], W['shift_mu'][l],
                                 W['w0'][l], W['w_up'][l], W['a0'][l], W['a_up'][l],
                                 W['k_k'][l], W['k_a'][l], W['r_k'][l], W['gn_g'][l], W['gn_b'][l], vres)
        if l == 0:
            v_first = v
        wkvs.append(S.astype(wkv0.dtype))
        shifts.append(last.astype(shift0.dtype))
        v_n = _layer_norm(vb_, W['ln_v_g'][l], W['ln_v_b'][l])
        chunk_vs.append(v_n)
        y_b = u * _chunk_spatial(v_n, W['w_spatial'][l], W['b_spatial'][l])
        br_a = (y_a * jax.nn.silu(g_a)) @ W['w_br_a'][l]
        br_b = (y_b * jax.nn.silu(g_b)) @ W['w_br_b'][l]
        merged = jax.nn.sigmoid(m_a) * br_a + jax.nn.sigmoid(m_b) * br_b
        h = h + merged @ W['w_out'][l]
        ple = p[l] @ W['w_ple'][l]
        h = h + jax.nn.sigmoid(h @ W['w_ple_gate'][l] + W['b_ple_gate'][l]) * ple
    y = _rms_norm(h, W['final_g'])
    return y, jnp.stack(wkvs), jnp.stack(shifts), jnp.stack(chunk_vs)


def setup_inputs(seed: int = 0) -> dict:
    key = jax.random.key(seed)
    ks = iter(jax.random.split(key, 64))
    f32 = jnp.float32
    nrm = lambda shape, s: jax.random.normal(next(ks), shape, f32) * s
    L = DEPTH
    return {
        'x_prompt': nrm((BATCH, SEQ, D_MODEL), 1.0),
        'x_sample': nrm((DEC_BATCH, DEC_SEQ, D_MODEL), 1.0),
        'state_rwkv_wkv': nrm((L, DEC_BATCH, N_HEADS_A, HEAD_A, HEAD_A), 0.5),
        'state_rwkv_shift': nrm((L, DEC_BATCH, N_SHIFT), 1.0),
        'p_prompt': nrm((L, BATCH, SEQ, D_PLE), 1.0),
        'p_sample': nrm((L, DEC_BATCH, DEC_SEQ, D_PLE), 1.0),
        'norm_g': 1.0 + nrm((L, D_MODEL), 0.05),
        'w_in': nrm((L, D_MODEL, D_IN), D_MODEL ** -0.5),
        'shift_mu': jax.random.uniform(next(ks), (L, N_SHIFT), f32),
        'w0': nrm((L, D_A), 0.5),
        'w_up': nrm((L, D_DECAY_LORA, D_A), 0.5 * D_DECAY_LORA ** -0.5),
        'a0': nrm((L, D_A), 0.5),
        'a_up': nrm((L, D_ICLR_LORA, D_A), 0.5 * D_ICLR_LORA ** -0.5),
        'vres_down': nrm((L - 1, D_MODEL, D_VRES_LORA), D_MODEL ** -0.5),
        'vres_up': nrm((L - 1, D_VRES_LORA, D_A), 0.5 * D_VRES_LORA ** -0.5),
        'vres_b': nrm((L - 1, D_A), 0.5),
        'k_k': 0.85 + nrm((L, D_A), 0.05),
        'k_a': 1.0 + nrm((L, D_A), 0.05),
        'r_k': nrm((L, N_HEADS_A, HEAD_A), 0.1),
        'gn_g': 1.0 + nrm((L, D_A), 0.05),
        'gn_b': nrm((L, D_A), 0.01),
        'ln_v_g': 1.0 + nrm((L, D_B), 0.05),
        'ln_v_b': nrm((L, D_B), 0.01),
        'w_spatial': nrm((L, N_GROUPS_B, CHUNK, CHUNK), CHUNK ** -0.5),
        'b_spatial': 1.0 + nrm((L, N_GROUPS_B, CHUNK), 0.1),
        'w_br_a': nrm((L, D_A, D_MODEL), D_A ** -0.5),
        'w_br_b': nrm((L, D_B, D_MODEL), D_B ** -0.5),
        'w_out': nrm((L, D_MODEL, D_MODEL), 0.5 * D_MODEL ** -0.5),
        'w_ple': nrm((L, D_PLE, D_MODEL), 0.5 * D_PLE ** -0.5),
        'w_ple_gate': nrm((L, D_MODEL, D_MODEL), D_MODEL ** -0.5),
        'b_ple_gate': nrm((L, D_MODEL), 0.01),
        'final_g': 1.0 + nrm((D_MODEL,), 0.05),
    }


def reference(x_prompt, x_sample, state_rwkv_wkv, state_rwkv_shift, p_prompt, p_sample,
              norm_g, w_in, shift_mu, w0, w_up, a0, a_up, vres_down, vres_up, vres_b,
              k_k, k_a, r_k, gn_g, gn_b, ln_v_g, ln_v_b, w_spatial, b_spatial,
              w_br_a, w_br_b, w_out, w_ple, w_ple_gate, b_ple_gate, final_g):
    W = dict(norm_g=norm_g, w_in=w_in, shift_mu=shift_mu, w0=w0, w_up=w_up, a0=a0, a_up=a_up,
             vres_down=vres_down, vres_up=vres_up, vres_b=vres_b, k_k=k_k, k_a=k_a, r_k=r_k,
             gn_g=gn_g, gn_b=gn_b, ln_v_g=ln_v_g, ln_v_b=ln_v_b, w_spatial=w_spatial,
             b_spatial=b_spatial, w_br_a=w_br_a, w_br_b=w_br_b, w_out=w_out, w_ple=w_ple,
             w_ple_gate=w_ple_gate, b_ple_gate=b_ple_gate, final_g=final_g)
    wkv0_p = jnp.zeros((DEPTH, x_prompt.shape[0], N_HEADS_A, HEAD_A, HEAD_A), state_rwkv_wkv.dtype)
    shift0_p = jnp.zeros((DEPTH, x_prompt.shape[0], N_SHIFT), state_rwkv_shift.dtype)
    y_prompt, wkv_prompt, shift_prompt, _ = _forward(x_prompt, p_prompt, wkv0_p, shift0_p, W)
    y_sample, wkv_sample, shift_sample, chunk_v_sample = _forward(
        x_sample, p_sample, state_rwkv_wkv, state_rwkv_shift, W)
    return (y_prompt, y_sample, wkv_prompt, shift_prompt, wkv_sample, shift_sample, chunk_v_sample)
```

```cpp
#include <hip/hip_runtime.h>
#include <hip/hip_cooperative_groups.h>
#include <cstdio>
#include <cstdint>
namespace cg = cooperative_groups;

#define LAS __attribute__((address_space(3)))
typedef unsigned short bf16_t;
typedef short bf16x8 __attribute__((ext_vector_type(8)));
typedef float f32x4 __attribute__((ext_vector_type(4)));
typedef float f32x2 __attribute__((ext_vector_type(2)));
typedef unsigned u32x4 __attribute__((ext_vector_type(4)));
typedef unsigned u32x2 __attribute__((ext_vector_type(2)));

constexpr int DM = 1024, NB = 8, SEQ = 2048, DEPTH = 2, NS = 128;
constexpr int MP = NB * SEQ;
constexpr int MR = MP + NS;
constexpr int MT = 16640;
constexpr int DA = 512, NH = 8, DB = 512, NSHIFT = 1664, DIN = 5760, DPLE = 256;
constexpr int N1 = 3072, N2 = 2816;
constexpr float EPS = 1e-6f, GN_EPS = 64e-5f;

constexpr size_t O_YP = 0, O_YS = (size_t)MP * DM, O_WKVP = O_YS + (size_t)NS * DM, O_SHP = O_WKVP + (size_t)DEPTH * NB * NH * 4096,
                 O_WKVS = O_SHP + (size_t)DEPTH * NB * NSHIFT, O_SHS = O_WKVS + (size_t)DEPTH * NS * NH * 4096, O_CV = O_SHS + (size_t)DEPTH * NS * NSHIFT;

constexpr size_t KiB = 1024, MiB = 1024 * 1024;
constexpr size_t S17 = (size_t)MT * 512 * 2, S34 = 2 * S17, S8 = (size_t)MT * 256 * 2;
constexpr size_t WS_SSQ = 64 * KiB;
constexpr size_t WS_RKP = WS_SSQ + 1088 * KiB;
constexpr size_t WS_HALO = 2240 * KiB;
constexpr size_t WS_WB = 3200 * KiB, WB_LAYER = 18 * MiB;
constexpr size_t WB_W1 = 0, WB_W2 = WB_W1 + (size_t)N1 * 1024 * 2, WB_BA = WB_W2 + (size_t)N2 * 1024 * 2, WB_BB = WB_BA + 1024 * 512 * 2,
                 WB_OUT = WB_BB + 1024 * 512 * 2, WB_PLE = WB_OUT + 1024 * 1024 * 2, WB_GATE = WB_PLE + 1024 * 256 * 2, WB_GATE_ALT = WB_LAYER;
static_assert(WB_GATE + 1024 * 1024 * 2 == WB_LAYER, "weight map");
constexpr size_t WS_XB = WS_WB + 20 * MiB;
constexpr size_t WS_PB = WS_XB + S34;
constexpr size_t WS_V0 = WS_PB + S8;
constexpr size_t WS_BRB = WS_V0 + S17;
constexpr size_t WS_G = WS_BRB + S34;
constexpr size_t G_U = WS_G, G_VB = G_U + S17, G_GB = G_VB + S17, G_MB = G_GB + S17;
constexpr size_t G_R = WS_G, G_K = G_R + S17, G_V = G_K + S17, G_LORA = G_V + S17, G_MA = G_LORA + S8, G_GA = G_MA + S34;
constexpr size_t WS_PKS = G_GA + S17;
constexpr size_t OS_Y = 0, OS_PKA4 = S17, OS_PLE = (size_t)MR * 2048;
constexpr size_t WS_LNS = WS_PKS + (size_t)1024 * 8 * 4608;
constexpr size_t WS_END = WS_LNS + (size_t)MT * 16 * 4;
static_assert(WS_HALO + 256 * 3584 <= WS_WB && WS_RKP + (size_t)MT * 16 * 4 <= WS_HALO && WS_SSQ + (size_t)MT * 16 * 4 + NS * 64 * 4 <= WS_RKP, "small tables");
static_assert(OS_PKA4 + (size_t)1024 * 8 * 2048 <= OS_PLE && OS_PLE + (size_t)MR * 2048 <= (size_t)MR * 1024 * 4, "scratch inside the hidden-state rows of d_out");
static_assert(WS_END <= 256 * MiB, "workspace");

__device__ __forceinline__ unsigned f2bf(float f) { return (unsigned)__builtin_bit_cast(unsigned short, (__bf16)f); }
typedef __bf16 bf16x2_hw __attribute__((ext_vector_type(2)));
__device__ __forceinline__ unsigned pk2(float lo, float hi) { return __builtin_bit_cast(unsigned, __builtin_convertvector((f32x2){lo, hi}, bf16x2_hw)); }
__device__ __forceinline__ float bf_lo(unsigned w) { return __builtin_bit_cast(float, w << 16); }
__device__ __forceinline__ float bf_hi(unsigned w) { return __builtin_bit_cast(float, w & 0xffff0000u); }
__device__ __forceinline__ float bf1(bf16_t h) { return __builtin_bit_cast(float, (unsigned)h << 16); }
__device__ __forceinline__ float fexp(float x) { return __builtin_amdgcn_exp2f(x * 1.44269504089f); }
__device__ __forceinline__ float frcp(float x) { return __builtin_amdgcn_rcpf(x); }
__device__ __forceinline__ float sigmoidf_(float x) { return frcp(1.0f + fexp(-x)); }
__device__ __forceinline__ float siluf_(float x) { return x * sigmoidf_(x); }
__device__ __forceinline__ float gelu_tanh(float x) { const float u = x + 0.044715f * x * x * x; return x * frcp(1.0f + fexp(-1.5957691216f * u)); }
__device__ __forceinline__ float tanhf_(float x) { return 1.0f - 2.0f * frcp(1.0f + fexp(2.0f * x)); }
template <int CTRL> __device__ __forceinline__ float dppmov(float x) { return __builtin_bit_cast(float, __builtin_amdgcn_update_dpp(0, __builtin_bit_cast(int, x), CTRL, 0xf, 0xf, true)); }
__device__ __forceinline__ float rowsum8(float x) { x += dppmov<0xB1>(x); x += dppmov<0x4E>(x); x += dppmov<0x141>(x); return x; }
__device__ __forceinline__ float rowsum16(float x) { x = rowsum8(x); x += dppmov<0x140>(x); return x; }
__device__ __forceinline__ float xrow_sum(float v) {
    const unsigned u = __builtin_bit_cast(unsigned, v);
    auto a = __builtin_amdgcn_permlane16_swap(u, u, false, false);
    const float s = __builtin_bit_cast(float, (unsigned)a[0]) + __builtin_bit_cast(float, (unsigned)a[1]);
    const unsigned w = __builtin_bit_cast(unsigned, s);
    auto b = __builtin_amdgcn_permlane32_swap(w, w, false, false);
    return __builtin_bit_cast(float, (unsigned)b[0]) + __builtin_bit_cast(float, (unsigned)b[1]);
}
__device__ __forceinline__ float wave_sum(float v) { return xrow_sum(rowsum16(v)); }
__device__ __forceinline__ f32x4 ld4bf(const bf16_t* p) { const u32x2 w = *(const u32x2*)p; return (f32x4){bf_lo(w.x), bf_hi(w.x), bf_lo(w.y), bf_hi(w.y)}; }
__device__ __forceinline__ bf16x8 pack_bf8(const f32x4 a, const f32x4 b) { u32x4 w; w.x = pk2(a[0], a[1]); w.y = pk2(a[2], a[3]); w.z = pk2(b[0], b[1]); w.w = pk2(b[2], b[3]); return __builtin_bit_cast(bf16x8, w); }
__device__ __forceinline__ float dot4(const f32x4 a, const f32x4 b) { return (a.x * b.x + a.y * b.y) + (a.z * b.z + a.w * b.w); }
__device__ __forceinline__ f32x4 up4(const u32x2 w) { return (f32x4){bf_lo(w.x), bf_hi(w.x), bf_lo(w.y), bf_hi(w.y)}; }
#define LDS_WAIT() asm volatile("s_waitcnt lgkmcnt(0)" ::: "memory")
__device__ __forceinline__ int opaque_tid(int wv) { int ln; asm volatile("v_mbcnt_lo_u32_b32 %0, -1, 0\n\tv_mbcnt_hi_u32_b32 %0, -1, %0" : "=v"(ln)); return wv * 64 + ln; }
template <class P> __device__ __forceinline__ P* opaque_ptr(P* p) { asm volatile("" : "+s"(p)); return p; }
__device__ __forceinline__ int opaque_s(int v) { asm volatile("" : "+s"(v)); return v; }


#define XB_TMO      128
#define XB_XCNT(j)  (256  + 64 * (j))
#define XB_XSUB(j)  (1280 + 64 * (j))
#define XB_XGEN(j)  (2304 + 64 * (j))
#define XB_TOP      3328
#define XB_TOPGEN   3392
#define XCD_BAR_WORDS 3456
#define XB_SPIN_CAP (1u << 18)
__device__ __forceinline__ unsigned xb_ld(unsigned* p)              { return __hip_atomic_load(p, __ATOMIC_RELAXED, __HIP_MEMORY_SCOPE_AGENT); }
__device__ __forceinline__ unsigned xb_add(unsigned* p, unsigned v) { return __hip_atomic_fetch_add(p, v, __ATOMIC_RELAXED, __HIP_MEMORY_SCOPE_AGENT); }
__device__ __forceinline__ unsigned xb_xcc_id() { return (unsigned)__builtin_amdgcn_s_getreg((3 << 11) | 20) & 0xFu; }
#define XB_SPIN(cond, bar) do { unsigned _sp = 0; while (cond) { __builtin_amdgcn_s_sleep(1); \
    if ((++_sp & 255u) == 0u) { if (xb_ld(&(bar)[XB_TMO])) break; if (_sp > XB_SPIN_CAP) { atomicAdd(&(bar)[XB_TMO], 1u); break; } } } } while (0)
struct XcdBarrier { unsigned* bar; unsigned x; volatile LAS unsigned* st; };
__device__ __forceinline__ XcdBarrier xcd_barrier_post(unsigned* bar, volatile LAS unsigned* st) {
    XcdBarrier b; b.bar = bar; b.x = xb_xcc_id(); b.st = st;
    if (threadIdx.x == 0) (void)xb_add(&bar[XB_XCNT(b.x)], 1u);
    return b;
}
__device__ __forceinline__ void xcd_barrier_complete(unsigned* bar, unsigned x, unsigned& nloc, unsigned& nx) {
    const unsigned G = gridDim.x * gridDim.y * gridDim.z;
    unsigned sum, cnt, mine, sp = 0u;
    for (;;) {
        sum = 0u; cnt = 0u; mine = 0u;
#pragma unroll
        for (unsigned j = 0; j < 16; ++j) { const unsigned c = xb_ld(&bar[XB_XCNT(j)]); sum += c; cnt += (c > 0u) ? 1u : 0u; mine = (j == x) ? c : mine; }
        if (sum == G) break;
        __builtin_amdgcn_s_sleep(1);
        if ((++sp & 255u) == 0u) { if (xb_ld(&bar[XB_TMO])) break; if (sp > XB_SPIN_CAP) { atomicAdd(&bar[XB_TMO], 1u); break; } }
    }
    nloc = mine > 0u ? mine : 1u; nx = cnt > 0u ? cnt : 1u;
}
__device__ __forceinline__ void xcd_barrier(const XcdBarrier& b, int wv) {
    asm volatile("s_waitcnt vmcnt(0)" ::: "memory");
    __syncthreads();
    if (opaque_tid(wv) == 0) {
        unsigned* bar = b.bar;
        __builtin_amdgcn_s_waitcnt(0);
        unsigned nloc = b.st[0], nx = b.st[1];
        if (nloc == 0u) { xcd_barrier_complete(bar, b.x, nloc, nx); b.st[0] = nloc; b.st[1] = nx; }
        const unsigned old = xb_add(&bar[XB_XSUB(b.x)], 1u);
        const unsigned gen = old / nloc;
        if (old + 1u == (gen + 1u) * nloc) {
            __builtin_amdgcn_fence(__ATOMIC_RELEASE, "agent");
            asm volatile("s_waitcnt vmcnt(0)" ::: "memory");
            const unsigned og = xb_add(&bar[XB_TOP], 1u);
            const unsigned tg = og / nx;
            if (og + 1u == (tg + 1u) * nx) xb_add(&bar[XB_TOPGEN], 1u);
            else XB_SPIN(xb_ld(&bar[XB_TOPGEN]) == tg, bar);
            __builtin_amdgcn_fence(__ATOMIC_ACQUIRE, "agent");
            xb_add(&bar[XB_XGEN(b.x)], 1u);
            asm volatile("s_waitcnt vmcnt(0)" ::: "memory");
        } else {
            XB_SPIN(xb_ld(&bar[XB_XGEN(b.x)]) == gen, bar);
            __builtin_amdgcn_fence(__ATOMIC_ACQUIRE, "agent");
            asm volatile("s_waitcnt vmcnt(0)" ::: "memory");
        }
    }
    __syncthreads();
}

namespace pg8 {
#define PG8_LAS __attribute__((address_space(3)))
constexpr int BM = 256, BK = 64, HALF = 128, HTB = HALF * BK * 2, STAGE_BYTES = 8 * HTB, NXCD = 8, WGM = 8;
__host__ __device__ __forceinline__ int lds_byte(int r, int c) { const int st = (r >> 4) * 2 + (c >> 5), rr = r & 15, cc = c & 31, ob = rr * 64 + cc * 2; return st * 1024 + (ob ^ (((ob >> 9) & 1) << 5)); }
__host__ __device__ __forceinline__ void stage_rc(int b, int& R, int& C) { const int st = b / 1024, sb = b % 1024, swz = sb ^ (((sb >> 9) & 1) << 5); R = (st >> 1) * 16 + swz / 64; C = (st & 1) * 32 + (swz % 64) / 2; }
__host__ __device__ __forceinline__ int perm32(int rho) { const int n = rho >> 4, i = rho & 15; return 8 * (i >> 2) + 4 * n + (i & 3); }
struct Unit { int pm, pn; };
struct Gemm { const bf16_t* A; const bf16_t* Bt; int M, N, K; };
struct StaticOrder {
    int nM, nN, nwg, G, c;
    __host__ __device__ void init(int M, int N, int G_, int c_) { nM = M / BM; nN = N / BM; nwg = nM * nN; G = G_; c = c_; }
    __host__ __device__ bool next(int i, Unit& u) const {
        const long L = (long)i * G + c; if (L >= nwg) return false;
        int wgid = (int)L; { const int q = nwg / NXCD, r = nwg % NXCD, xcd = wgid % NXCD, off = wgid / NXCD; wgid = (xcd < r ? xcd * (q + 1) : r * (q + 1) + (xcd - r) * q) + off; }
        const int nig = WGM * nN, gid = wgid / nig, fm = gid * WGM, gsz = (nM - fm) < WGM ? (nM - fm) : WGM;
        u.pm = fm + ((wgid % nig) % gsz); u.pn = (wgid % nig) / gsz; return true;
    }
    __device__ __forceinline__ void a_ready(const Unit&) const {}
    __device__ __forceinline__ void done(const Unit&) const {}
};

struct NoMid { __device__ __forceinline__ void operator()() const {} };
template <class Epi, class Sched, bool ALIGN_EPI = false, bool SP2 = false, class Mid = NoMid>
__device__ __forceinline__ void gemm_phase(PG8_LAS unsigned char* lds, const Gemm g, const Sched& S, const Epi& E, int wv, const Mid& mid = Mid()) {
    const int tid = opaque_tid(wv), wid = __builtin_amdgcn_readfirstlane(tid >> 6), lane = tid & 63, wr = wid >> 2, wc = wid & 3, fr = lane & 15, fq = lane >> 4;
    const int K = g.K, nt = K / BK;
    unsigned voffA[2], voffB[2];
#pragma unroll
    for (int i = 0; i < 2; ++i) { int R, C; stage_rc(tid * 16 + i * 8192, R, C); const int Rb = Epi::PERM ? ((R & ~31) + perm32(R & 31)) : R;
        voffA[i] = (unsigned)(R * K + C) * 2u; voffB[i] = (unsigned)(Rb * K + C) * 2u; }
    const size_t kstep = (size_t)(BK * 2);
    const size_t hstep = (size_t)HALF * K * 2;
    const size_t tstep = 2 * hstep;
    const unsigned ldsw = (unsigned)wid * 1024u;
    const int aoff = lds_byte(wr * 64 + fr, fq * 8), boff = lds_byte(wc * 32 + fr, fq * 8);
#define PG8_SA(b, h) (((b) * 2 + (h)) * HTB)
#define PG8_SB(b, h) ((4 + (b) * 2 + (h)) * HTB)
#define PG8_STAGE(bufoff, gbase, voff) do { _Pragma("unroll") for (int _i = 0; _i < 2; ++_i) \
        __builtin_amdgcn_global_load_lds((const unsigned*)((const char*)(gbase) + (voff)[_i]), (PG8_LAS unsigned*)(lds + (bufoff) + ldsw + _i * 8192), 16, 0, 0); } while (0)
#define PG8_LDA(dst, b, h) do { _Pragma("unroll") for (int m = 0; m < 4; ++m) _Pragma("unroll") for (int k = 0; k < 2; ++k) dst[m][k] = *(const PG8_LAS bf16x8*)(lds + PG8_SA(b, h) + aoff + m * 2048 + k * 1024); } while (0)
#define PG8_LDB(dst, b, h) do { _Pragma("unroll") for (int n = 0; n < 2; ++n) _Pragma("unroll") for (int k = 0; k < 2; ++k) dst[n][k] = *(const PG8_LAS bf16x8*)(lds + PG8_SB(b, h) + boff + n * 2048 + k * 1024); } while (0)
#define PG8_MMA(ai, bj, At, Bt) do { __builtin_amdgcn_s_setprio(1); _Pragma("unroll") for (int m = 0; m < 4; ++m) _Pragma("unroll") for (int n = 0; n < 2; ++n) _Pragma("unroll") for (int k = 0; k < 2; ++k) \
        acc[ai][bj][m][n] = __builtin_amdgcn_mfma_f32_16x16x32_bf16(Bt[n][k], At[m][k], acc[ai][bj][m][n], 0, 0, 0); __builtin_amdgcn_s_setprio(0); } while (0)
#define PG8_WAIT_V(n) asm volatile("s_waitcnt vmcnt(" #n ")" ::: "memory")
#define PG8_WAIT_L(n) asm volatile("s_waitcnt lgkmcnt(" #n ")" ::: "memory")
#define PG8_BAR __builtin_amdgcn_s_barrier()
#define PG8_SCHED __builtin_amdgcn_sched_barrier(0)
    Unit cur, nxt; int ui = 0;
    if (!S.next(0, cur)) return;
    f32x4 acc[2][2][4][2];
#pragma unroll
    for (int a = 0; a < 2; ++a)
#pragma unroll
        for (int b = 0; b < 2; ++b)
#pragma unroll
            for (int m = 0; m < 4; ++m)
#pragma unroll
                for (int n = 0; n < 2; ++n) acc[a][b][m][n] = (f32x4){0.f, 0.f, 0.f, 0.f};
    bf16x8 At[4][2], B0[2][2], B1[2][2];
    const char* cA = (const char*)g.A + (size_t)cur.pm * tstep; const char* cB = (const char*)g.Bt + (size_t)cur.pn * tstep;
    S.a_ready(cur);
    if constexpr (SP2) {
        PG8_STAGE(PG8_SB(0, 0), cB, voffB); PG8_STAGE(PG8_SB(0, 1), cB + hstep, voffB); PG8_STAGE(PG8_SA(0, 0), cA, voffA); PG8_STAGE(PG8_SA(0, 1), cA + hstep, voffA);
        mid();
        if (wr == 1) PG8_BAR;
        PG8_WAIT_V(2); PG8_BAR;
        PG8_STAGE(PG8_SB(1, 0), cB + kstep, voffB); PG8_STAGE(PG8_SA(1, 0), cA + kstep, voffA); PG8_STAGE(PG8_SB(1, 1), cB + hstep + kstep, voffB);
        PG8_WAIT_V(6); PG8_BAR;
    } else {
        PG8_STAGE(PG8_SB(0, 0), cB, voffB); PG8_STAGE(PG8_SA(0, 0), cA, voffA); PG8_STAGE(PG8_SB(0, 1), cB + hstep, voffB); PG8_STAGE(PG8_SA(0, 1), cA + hstep, voffA);
        if (wr == 1) PG8_BAR;
        PG8_WAIT_V(4); PG8_BAR;
        PG8_STAGE(PG8_SB(1, 0), cB + kstep, voffB); PG8_STAGE(PG8_SA(1, 0), cA + kstep, voffA); PG8_STAGE(PG8_SB(1, 1), cB + hstep + kstep, voffB);
        PG8_WAIT_V(6); PG8_BAR;
    }
    for (;;) {
        const bool has_next = S.next(ui + 1, nxt);
        const char* nA = has_next ? (const char*)g.A + (size_t)nxt.pm * tstep : cA; const char* nB = has_next ? (const char*)g.Bt + (size_t)nxt.pn * tstep : cB;
        for (int t = 0; t < nt; t += 2) {
            const bool last = (t == nt - 2);
            const char* a1 = cA + (size_t)(t + 1) * kstep;
            const char* a2 = last ? nA : cA + (size_t)(t + 2) * kstep; const char* b2 = last ? nB : cB + (size_t)(t + 2) * kstep;
            const char* a3 = a2 + kstep; const char* b3 = b2 + kstep;
            if (last && has_next) S.a_ready(nxt);
            if constexpr (SP2) {
            PG8_LDB(B0, 0, 0); PG8_LDB(B1, 0, 1); PG8_SCHED; PG8_LDA(At, 0, 0); PG8_STAGE(PG8_SA(1, 1), a1 + hstep, voffA);
            PG8_WAIT_V(8); PG8_WAIT_L(0); PG8_BAR; PG8_MMA(0, 0, At, B0); PG8_MMA(0, 1, At, B1); PG8_BAR; PG8_SCHED;
            PG8_LDA(At, 0, 1); PG8_STAGE(PG8_SB(0, 0), b2, voffB); PG8_STAGE(PG8_SB(0, 1), b2 + hstep, voffB); PG8_STAGE(PG8_SA(0, 0), a2, voffA);
            PG8_WAIT_V(8); PG8_WAIT_L(0); PG8_BAR; PG8_MMA(1, 0, At, B0); PG8_MMA(1, 1, At, B1); PG8_BAR; PG8_SCHED;
            PG8_LDB(B0, 1, 0); PG8_LDB(B1, 1, 1); PG8_SCHED; PG8_LDA(At, 1, 0); PG8_STAGE(PG8_SA(0, 1), a2 + hstep, voffA);
            PG8_WAIT_V(8); PG8_WAIT_L(0); PG8_BAR; PG8_MMA(0, 0, At, B0); PG8_MMA(0, 1, At, B1); PG8_BAR; PG8_SCHED;
            PG8_LDA(At, 1, 1); PG8_STAGE(PG8_SB(1, 0), b3, voffB); PG8_STAGE(PG8_SB(1, 1), b3 + hstep, voffB); PG8_STAGE(PG8_SA(1, 0), a3, voffA);
            PG8_WAIT_V(8); PG8_WAIT_L(0); PG8_BAR; PG8_MMA(1, 0, At, B0); PG8_MMA(1, 1, At, B1); PG8_BAR; PG8_SCHED;
            } else {
            PG8_LDB(B0, 0, 0); PG8_SCHED; PG8_LDA(At, 0, 0); PG8_STAGE(PG8_SA(1, 1), a1 + hstep, voffA);
            PG8_WAIT_L(8); PG8_BAR; PG8_WAIT_L(0); PG8_MMA(0, 0, At, B0); PG8_BAR; PG8_SCHED;
            PG8_LDB(B1, 0, 1); PG8_STAGE(PG8_SB(0, 0), b2, voffB);
            PG8_BAR; PG8_WAIT_L(0); PG8_MMA(0, 1, At, B1); PG8_BAR;
            PG8_LDA(At, 0, 1); PG8_STAGE(PG8_SA(0, 0), a2, voffA);
            PG8_BAR; PG8_WAIT_L(0); PG8_MMA(1, 0, At, B0); PG8_BAR; PG8_SCHED;
            PG8_STAGE(PG8_SB(0, 1), b2 + hstep, voffB);
            PG8_WAIT_V(6); PG8_BAR; PG8_MMA(1, 1, At, B1); PG8_BAR;
            PG8_LDB(B0, 1, 0); PG8_SCHED; PG8_LDA(At, 1, 0); PG8_STAGE(PG8_SA(0, 1), a2 + hstep, voffA);
            PG8_WAIT_L(8); PG8_BAR; PG8_WAIT_L(0); PG8_MMA(0, 0, At, B0); PG8_BAR; PG8_SCHED;
            PG8_LDB(B1, 1, 1); PG8_STAGE(PG8_SB(1, 0), b3, voffB);
            PG8_BAR; PG8_WAIT_L(0); PG8_MMA(0, 1, At, B1); PG8_BAR;
            PG8_LDA(At, 1, 1); PG8_STAGE(PG8_SA(1, 0), a3, voffA);
            PG8_BAR; PG8_WAIT_L(0); PG8_MMA(1, 0, At, B0); PG8_BAR; PG8_SCHED;
            PG8_STAGE(PG8_SB(1, 1), b3 + hstep, voffB);
            PG8_WAIT_V(6); PG8_BAR; PG8_MMA(1, 1, At, B1); PG8_BAR;
            }
        }
        if constexpr (ALIGN_EPI) { if (wr == 0) PG8_BAR; }
        if constexpr (!Epi::AFTER_DRAIN) { E(acc, cur, wr, wc, fr, fq); S.done(cur); }
        if (!has_next) break;
#pragma unroll
        for (int a = 0; a < 2; ++a)
#pragma unroll
            for (int b = 0; b < 2; ++b)
#pragma unroll
                for (int m = 0; m < 4; ++m)
#pragma unroll
                    for (int n = 0; n < 2; ++n) acc[a][b][m][n] = (f32x4){0.f, 0.f, 0.f, 0.f};
        cur = nxt; cA = nA; cB = nB; ++ui;
        if constexpr (ALIGN_EPI) { if (wr == 1) PG8_BAR; }
    }
    PG8_WAIT_V(0);
    if constexpr (!ALIGN_EPI) { if (wr == 0) PG8_BAR; }
    PG8_BAR;
    if constexpr (Epi::AFTER_DRAIN) { E.fused(acc, cur, wr, wc, fr, fq, lds, wid, lane); S.done(cur); }
#undef PG8_SA
#undef PG8_SB
#undef PG8_STAGE
#undef PG8_LDA
#undef PG8_LDB
#undef PG8_MMA
#undef PG8_WAIT_V
#undef PG8_WAIT_L
#undef PG8_BAR
#undef PG8_SCHED
}
}
using pg8::Unit;

__device__ __forceinline__ float row_rstd(const float* ssq, int row) {
    float s;
    if (row >= MP && row < MR) { const f32x4* p = (const f32x4*)(ssq + (size_t)MT * 16 + (size_t)(row - MP) * 64); f32x4 t = p[0];
#pragma unroll
        for (int i = 1; i < 16; ++i) t = t + p[i];
        s = (t.x + t.y) + (t.z + t.w); }
    else { const f32x4* p = (const f32x4*)(ssq + (size_t)row * 16);
        const f32x4 a = p[0], b = p[1], c = p[2], d = p[3];
        s = ((a.x + a.y) + (a.z + a.w)) + ((b.x + b.y) + (b.z + b.w)) + ((c.x + c.y) + (c.z + c.w)) + ((d.x + d.y) + (d.z + d.w)); }
    return __builtin_amdgcn_rsqf(s * (1.0f / 1024.0f) + EPS);
}
__device__ __forceinline__ void act8(int act, f32x4& a, f32x4& b) {
    if (act == 1) { for (int i = 0; i < 4; ++i) { a[i] = gelu_tanh(a[i]); b[i] = gelu_tanh(b[i]); } }
    else if (act == 2) { for (int i = 0; i < 4; ++i) { a[i] = siluf_(a[i]); b[i] = siluf_(b[i]); } }
    else if (act == 3) { for (int i = 0; i < 4; ++i) { a[i] = sigmoidf_(a[i]); b[i] = sigmoidf_(b[i]); } }
}
__device__ __forceinline__ u32x4 pack8(const f32x4& a, const f32x4& b) { u32x4 w; w.x = pk2(a[0], a[1]); w.y = pk2(a[2], a[3]); w.z = pk2(b[0], b[1]); w.w = pk2(b[2], b[3]); return w; }
__device__ __forceinline__ void wt16(void* base, unsigned off, const u32x4 v) { const __amdgpu_buffer_rsrc_t rs = __builtin_amdgcn_make_buffer_rsrc(base, (short)0, 0x7fffffff, 0x00020000); __builtin_amdgcn_raw_buffer_store_b128(v, rs, (int)off, 0, 16); }
__device__ __forceinline__ void unpack8(const u32x4& w, f32x4& a, f32x4& b) { a[0] = bf_lo(w.x); a[1] = bf_hi(w.x); a[2] = bf_lo(w.y); a[3] = bf_hi(w.y); b[0] = bf_lo(w.z); b[1] = bf_hi(w.z); b[2] = bf_lo(w.w); b[3] = bf_hi(w.w); }

struct EpiG1 {
    static constexpr bool PERM = true, AFTER_DRAIN = false;
    bf16_t *U, *VB, *GB, *MB, *GA; const float* ssq; float* lns;
    __device__ __forceinline__ void operator()(const f32x4 (&acc)[2][2][4][2], const Unit& u, int wr, int wc, int fr, int fq) const {
        const int pn = u.pn; bf16_t* base; int ldc, colt, act;
        if (pn < 2) { base = U; ldc = 512; colt = pn * 256; act = 1; }
        else if (pn < 4) { base = VB; ldc = 512; colt = (pn - 2) * 256; act = 1; }
        else if (pn < 6) { base = GB; ldc = 512; colt = (pn - 4) * 256; act = 2; }
        else if (pn < 10) { base = MB; ldc = 1024; colt = (pn - 6) * 256; act = 3; }
        else { base = GA; ldc = 512; colt = (pn - 10) * 256; act = 2; }
        const int row0 = u.pm * 256 + wr * 64 + fr, col0 = colt + wc * 32 + 8 * fq;
#pragma unroll
        for (int ai = 0; ai < 2; ++ai)
#pragma unroll
            for (int m = 0; m < 4; ++m) { const int row = row0 + ai * 128 + m * 16; const float rs = row_rstd(ssq, row); bf16_t* rowp = base + (size_t)row * ldc + col0;
                float s1 = 0.f, s2 = 0.f;
#pragma unroll
                for (int bj = 0; bj < 2; ++bj) { f32x4 v0 = acc[ai][bj][m][0] * rs, v1 = acc[ai][bj][m][1] * rs; act8(act, v0, v1); *(u32x4*)(rowp + bj * 128) = pack8(v0, v1);
                    s1 += ((v0[0] + v0[1]) + (v0[2] + v0[3])) + ((v1[0] + v1[1]) + (v1[2] + v1[3])); s2 += dot4(v0, v0) + dot4(v1, v1); }
                if (pn == 2 || pn == 3) {
                    s1 = xrow_sum(s1); s2 = xrow_sum(s2);
                    if (fq == 0) *(f32x2*)(lns + (size_t)row * 16 + ((pn - 2) * 4 + wc) * 2) = (f32x2){s1, s2}; } }
    }
};
struct EpiG2 {
    static constexpr bool PERM = true, AFTER_DRAIN = false;
    bf16_t *R, *K, *V, *LORA, *MA; const float* ssq; float* shp; float* shs; bf16_t* HALO;
    __device__ __forceinline__ void operator()(const f32x4 (&acc)[2][2][4][2], const Unit& u, int wr, int wc, int fr, int fq) const {
        const int pn = u.pn; bf16_t* base; int ldc, colt, act = 0;
        if (pn < 2) { base = R; ldc = 512; colt = pn * 256; }
        else if (pn < 4) { base = K; ldc = 512; colt = (pn - 2) * 256; }
        else if (pn < 6) { base = V; ldc = 512; colt = (pn - 4) * 256; }
        else if (pn == 6) { base = LORA; ldc = 256; colt = 0; }
        else { base = MA; ldc = 1024; colt = (pn - 7) * 256; act = 3; }
        const int row0 = u.pm * 256 + wr * 64 + fr, col0 = colt + wc * 32 + 8 * fq;
        const int ocol0 = pn * 256 + wc * 32 + 8 * fq;
#pragma unroll
        for (int ai = 0; ai < 2; ++ai)
#pragma unroll
            for (int m = 0; m < 4; ++m) { const int row = row0 + ai * 128 + m * 16; const float rs = row_rstd(ssq, row); bf16_t* rowp = base + (size_t)row * ldc + col0;
                float* sh = nullptr;
                if (pn <= 6) { if (row < MP) { if ((row & (SEQ - 1)) == SEQ - 1) sh = shp + (size_t)(row >> 11) * NSHIFT; } else if (row < MR) sh = shs + (size_t)(row - MP) * NSHIFT; }
                bf16_t* hrow = (pn <= 6 && row < MP && (row & 63) == 63 && (row >> 6) + 1 < 256) ? HALO + (size_t)((row >> 6) + 1) * 1792 + (pn < 6 ? (pn >> 1) * 512 : 1536) + col0 : nullptr;
#pragma unroll
                for (int bj = 0; bj < 2; ++bj) { f32x4 v0 = acc[ai][bj][m][0] * rs, v1 = acc[ai][bj][m][1] * rs;
                    if (sh != nullptr && (pn < 6 || bj == 0)) { float* o = sh + ocol0 + bj * 128; *(f32x4*)o = v0; *(f32x4*)(o + 4) = v1; }
                    act8(act, v0, v1); const u32x4 pk = pack8(v0, v1); *(u32x4*)(rowp + bj * 128) = pk;
                    if (hrow != nullptr && (pn < 6 || bj == 0)) *(u32x4*)(hrow + bj * 128) = pk; } }
    }
};
struct EpiMulAdd {
    static constexpr bool PERM = true, AFTER_DRAIN = false;
    bf16_t* O; const bf16_t* M1; const bf16_t* ADD;
    __device__ __forceinline__ void operator()(const f32x4 (&acc)[2][2][4][2], const Unit& u, int wr, int wc, int fr, int fq) const {
        const int row0 = u.pm * 256 + wr * 64 + fr, col0 = u.pn * 256 + wc * 32 + 8 * fq;
#pragma unroll
        for (int ai = 0; ai < 2; ++ai)
#pragma unroll
            for (int m = 0; m < 4; ++m) { const size_t off = (size_t)(row0 + ai * 128 + m * 16) * 1024 + col0;
#pragma unroll
                for (int bj = 0; bj < 2; ++bj) { f32x4 v0 = acc[ai][bj][m][0], v1 = acc[ai][bj][m][1];
                    if (M1) { f32x4 g0, g1; unpack8(*(const u32x4*)(M1 + off + bj * 128), g0, g1); v0 = v0 * g0; v1 = v1 * g1; }
                    if (ADD) { f32x4 g0, g1; unpack8(*(const u32x4*)(ADD + off + bj * 128), g0, g1); v0 = v0 + g0; v1 = v1 + g1; }
                    *(u32x4*)(O + off + bj * 128) = pack8(v0, v1); } }
    }
};
struct EpiOut {
    static constexpr bool PERM = false, AFTER_DRAIN = false;
    const float* xp; const float* xs; float* H; bf16_t* H1B; int first;
    __device__ __forceinline__ void operator()(const f32x4 (&acc)[2][2][4][2], const Unit& u, int wr, int wc, int fr, int fq) const {
        const int row0 = u.pm * 256 + wr * 64 + fr, col0 = u.pn * 256 + wc * 32 + 4 * fq;
#pragma unroll
        for (int ai = 0; ai < 2; ++ai)
#pragma unroll
            for (int m = 0; m < 4; ++m) { const int row = row0 + ai * 128 + m * 16; const bool real = row < MR;
                const float* hin = first ? (row < MP ? xp + (size_t)row * 1024 : xs + (size_t)(row - MP) * 1024) : H + (size_t)row * 1024;
#pragma unroll
                for (int bj = 0; bj < 2; ++bj)
#pragma unroll
                    for (int n = 0; n < 2; ++n) { const int c = col0 + bj * 128 + n * 16; f32x4 h = (f32x4){0.f, 0.f, 0.f, 0.f};
                        if (real) h = *(const f32x4*)(hin + c);
                        h = h + acc[ai][bj][m][n];
                        if (real) *(f32x4*)(H + (size_t)row * 1024 + c) = h;
                        u32x2 w; w.x = pk2(h[0], h[1]); w.y = pk2(h[2], h[3]); *(u32x2*)(H1B + (size_t)row * 1024 + c) = w; } }
    }
};
struct EpiGate {
    static constexpr bool PERM = false, AFTER_DRAIN = false;
    float* H; const bf16_t* PLE; const float* bias; bf16_t* XB; float* ssq;
    __device__ __forceinline__ void operator()(const f32x4 (&acc)[2][2][4][2], const Unit& u, int wr, int wc, int fr, int fq) const {
        const int row0 = u.pm * 256 + wr * 64 + fr, col0 = u.pn * 256 + wc * 32 + 4 * fq;
        f32x4 bv[2][2];
#pragma unroll
        for (int bj = 0; bj < 2; ++bj)
#pragma unroll
            for (int n = 0; n < 2; ++n) bv[bj][n] = *(const f32x4*)(bias + col0 + bj * 128 + n * 16);
#pragma unroll
        for (int ai = 0; ai < 2; ++ai)
#pragma unroll
            for (int m = 0; m < 4; ++m) { const int row = row0 + ai * 128 + m * 16; const bool real = row < MR; float ss = 0.f;
#pragma unroll
                for (int bj = 0; bj < 2; ++bj)
#pragma unroll
                    for (int n = 0; n < 2; ++n) { const int c = col0 + bj * 128 + n * 16; const size_t off = (size_t)row * 1024 + c;
                        f32x4 h = (f32x4){0.f, 0.f, 0.f, 0.f}; if (real) h = *(const f32x4*)(H + off);
                        const u32x2 pw = *(const u32x2*)(PLE + off);
                        const f32x4 a = acc[ai][bj][m][n] + bv[bj][n];
                        h[0] += sigmoidf_(a[0]) * bf_lo(pw.x); h[1] += sigmoidf_(a[1]) * bf_hi(pw.x); h[2] += sigmoidf_(a[2]) * bf_lo(pw.y); h[3] += sigmoidf_(a[3]) * bf_hi(pw.y);
                        if (real) *(f32x4*)(H + off) = h;
                        ss += (h[0] * h[0] + h[1] * h[1]) + (h[2] * h[2] + h[3] * h[3]);
                        u32x2 w; w.x = pk2(h[0], h[1]); w.y = pk2(h[2], h[3]); *(u32x2*)(XB + off) = w; }
                ss = xrow_sum(ss);
                if (fq == 0) ssq[(size_t)row * 16 + u.pn * 4 + wc] = ss; }
    }
};


struct U8 { u32x4 a, b; };
__device__ __forceinline__ float half_sum(float v) {
    const unsigned u = __builtin_bit_cast(unsigned, rowsum16(v));
    auto a = __builtin_amdgcn_permlane16_swap(u, u, false, false);
    return __builtin_bit_cast(float, (unsigned)a[0]) + __builtin_bit_cast(float, (unsigned)a[1]);
}
template <bool PERM, class Pre, class Fin>
__device__ __forceinline__ void staged_rows(const f32x4 (&acc)[2][2][4][2], const Unit& u, int wr, int wc, int fr, int fq, LAS unsigned char* lds, int wid, int lane, const Pre& pre, const Fin& fin) {
    LAS f32x4* T4 = (LAS f32x4*)lds;
    const int hl = lane >> 5, c8 = lane & 31;
#pragma unroll
    for (int ai = 0; ai < 2; ++ai) {
        decltype(pre(0, 0)) pv[8];
#pragma unroll
        for (int i = 0; i < 8; ++i) pv[i] = pre(u.pm * 256 + 128 * ai + 16 * wid + 2 * i + hl, c8);
#pragma unroll
        for (int m = 0; m < 4; ++m) { const int rl = 64 * wr + 16 * m + fr;
#pragma unroll
            for (int bj = 0; bj < 2; ++bj)
#pragma unroll
                for (int n = 0; n < 2; ++n) { const int ch = PERM ? 32 * bj + 8 * wc + 2 * fq + n : 32 * bj + 8 * wc + 4 * n + fq; T4[rl * 64 + (ch ^ (rl & 15))] = acc[ai][bj][m][n]; } }
        asm volatile("s_waitcnt lgkmcnt(0)" ::: "memory"); __builtin_amdgcn_s_barrier(); asm volatile("" ::: "memory");
#pragma unroll
        for (int i = 0; i < 8; ++i) { const int rl = 16 * wid + 2 * i + hl; const f32x4 v0 = T4[rl * 64 + ((2 * c8) ^ (rl & 15))], v1 = T4[rl * 64 + ((2 * c8 + 1) ^ (rl & 15))];
            fin(u.pm * 256 + 128 * ai + rl, c8, v0, v1, pv[i]); }
        asm volatile("s_waitcnt lgkmcnt(0)" ::: "memory"); __builtin_amdgcn_s_barrier(); asm volatile("" ::: "memory");
    }
}
struct EpiOutS {
    static constexpr bool PERM = false, AFTER_DRAIN = true;
    const bf16_t* hin; bf16_t* H1B;
    __device__ __forceinline__ void fused(const f32x4 (&acc)[2][2][4][2], const Unit& u, int wr, int wc, int fr, int fq, LAS unsigned char* lds, int wid, int lane) const {
        const bf16_t* hi = hin; bf16_t* ho = H1B; const int pn = u.pn;
        staged_rows<false>(acc, u, wr, wc, fr, fq, lds, wid, lane,
            [=](int row, int c8) { return *(const u32x4*)(hi + (size_t)row * 1024 + pn * 256 + 8 * c8); },
            [=](int row, int c8, f32x4 v0, f32x4 v1, u32x4 hv) { f32x4 h0, h1; unpack8(hv, h0, h1); wt16(ho, (unsigned)(((size_t)row * 1024 + pn * 256 + 8 * c8) * 2), pack8(h0 + v0, h1 + v1)); });
    }
};
struct EpiGateS {
    static constexpr bool PERM = false, AFTER_DRAIN = true;
    const bf16_t* H1B; const bf16_t* PLE; const float* bias; bf16_t* XB; float* ssq;
    __device__ __forceinline__ void fused(const f32x4 (&acc)[2][2][4][2], const Unit& u, int wr, int wc, int fr, int fq, LAS unsigned char* lds, int wid, int lane) const {
        const bf16_t* h1p = H1B; const bf16_t* pl = PLE; bf16_t* xb = XB; float* sq = ssq; const int pn = u.pn;
        const f32x4 bv0 = *(const f32x4*)(bias + pn * 256 + 8 * (lane & 31)), bv1 = *(const f32x4*)(bias + pn * 256 + 8 * (lane & 31) + 4);
        staged_rows<false>(acc, u, wr, wc, fr, fq, lds, wid, lane,
            [=](int row, int c8) { const size_t off = (size_t)row * 1024 + pn * 256 + 8 * c8; U8 r; r.a = *(const u32x4*)(h1p + off); r.b = *(const u32x4*)(pl + off); return r; },
            [=](int row, int c8, f32x4 v0, f32x4 v1, U8 pr) { const size_t off = (size_t)row * 1024 + pn * 256 + 8 * c8;
                f32x4 h0, h1, p0, p1; unpack8(pr.a, h0, h1); unpack8(pr.b, p0, p1); const f32x4 a0 = v0 + bv0, a1 = v1 + bv1;
#pragma unroll
                for (int e = 0; e < 4; ++e) { h0[e] += sigmoidf_(a0[e]) * p0[e]; h1[e] += sigmoidf_(a1[e]) * p1[e]; }
                wt16(xb, (unsigned)(off * 2), pack8(h0, h1));
                const float ss = half_sum(dot4(h0, h0) + dot4(h1, h1));
                if (c8 < 4) sq[(size_t)row * 16 + pn * 4 + c8] = c8 == 0 ? ss : 0.f; });
    }
};

struct EpiMulAddS {
    static constexpr bool PERM = true, AFTER_DRAIN = true;
    bf16_t* O; const bf16_t* M1; const bf16_t* ADD;
    __device__ __forceinline__ void fused(const f32x4 (&acc)[2][2][4][2], const Unit& u, int wr, int wc, int fr, int fq, LAS unsigned char* lds, int wid, int lane) const {
        bf16_t* o = O; const bf16_t* m1 = M1; const bf16_t* ad = ADD; const int pn = u.pn;
        staged_rows<true>(acc, u, wr, wc, fr, fq, lds, wid, lane,
            [=](int row, int c8) { const size_t off = (size_t)row * 1024 + pn * 256 + 8 * c8; U8 r; r.a = (u32x4){0u, 0u, 0u, 0u}; r.b = r.a;
                if (m1) r.a = *(const u32x4*)(m1 + off); if (ad) r.b = *(const u32x4*)(ad + off); return r; },
            [=](int row, int c8, f32x4 v0, f32x4 v1, U8 pr) { const size_t off = (size_t)row * 1024 + pn * 256 + 8 * c8;
                if (m1) { f32x4 g0, g1; unpack8(pr.a, g0, g1); v0 = v0 * g0; v1 = v1 * g1; } if (ad) { f32x4 g0, g1; unpack8(pr.b, g0, g1); v0 = v0 + g0; v1 = v1 + g1; }
                wt16(o, (unsigned)(off * 2), pack8(v0, v1)); });
    }
};

template <int K, int NT, class Pre, class Fin>
__device__ __forceinline__ void mini_gemm(const bf16_t* Afull, const bf16_t* Bt, LAS unsigned char* lds, int task, int tid, const Pre& pre, const Fin& fin, int ncb = 16) {
    const int wave = __builtin_amdgcn_readfirstlane(tid >> 6), lane = tid & 63, r = lane & 15, kq = lane >> 4, rb = task / ncb, cb = task % ncb;
    constexpr int kper = K >> 3, NST = kper / 32;
    const int k0 = wave * kper;
    f32x4 acc[NT];
#pragma unroll
    for (int n = 0; n < NT; ++n) acc[n] = (f32x4){0.f, 0.f, 0.f, 0.f};
    const bf16_t* ap = Afull + (size_t)(MP + 16 * rb + r) * K + k0 + 8 * kq;
    const bf16_t* bp = Bt + (size_t)(16 * NT * cb + r) * K + k0 + 8 * kq;
    bf16x8 af[NST], bfr[NST][NT];
    const int erow = MP + 16 * rb + r, ecol = 16 * NT * cb + 16 * (wave < NT ? wave : 0) + 4 * kq;
#pragma unroll
    for (int st = 0; st < NST; ++st) { af[st] = *(const bf16x8*)(ap + 32 * st);
#pragma unroll
        for (int n = 0; n < NT; ++n) bfr[st][n] = *(const bf16x8*)(bp + (size_t)(16 * n) * K + 32 * st); }
    decltype(pre(0, 0)) pv = pre(erow, ecol);
#pragma unroll
    for (int st = 0; st < NST; ++st)
#pragma unroll
        for (int n = 0; n < NT; ++n) acc[n] = __builtin_amdgcn_mfma_f32_16x16x32_bf16(bfr[st][n], af[st], acc[n], 0, 0, 0);
    LAS f32x4* red = (LAS f32x4*)lds;
#pragma unroll
    for (int n = 0; n < NT; ++n) if (wave != n) red[(n * 7 + (wave < n ? wave : wave - 1)) * 64 + lane] = acc[n];
    __syncthreads();
    if (wave < NT) { f32x4 v = acc[0];
#pragma unroll
        for (int n = 1; n < NT; ++n) v = wave == n ? acc[n] : v;
#pragma unroll
        for (int w = 0; w < 7; ++w) v = v + red[(wave * 7 + w) * 64 + lane];
        fin(erow, ecol, v, pv); }
    __syncthreads();
}

struct Args { const float* in[32]; float* out; unsigned char* ws; };
typedef const __attribute__((address_space(4))) Args* CArgs;
__device__ __forceinline__ Args load_args(CArgs p) {
    asm volatile("" : "+s"(p));
    Args a;
#pragma unroll
    for (int i = 0; i < 32; ++i) a.in[i] = p->in[i];
    a.out = p->out; a.ws = p->ws; return a;
}

template <class V> __device__ __forceinline__ V ldo(const void* base, unsigned off) { return *(const V*)((const char*)base + off); }
template <class V> __device__ __forceinline__ void sto(void* base, unsigned off, const V& v) { *(V*)((char*)base + off) = v; }
__device__ __forceinline__ void transpose_item(const float* W, int ldw, int src_col0, bf16_t* WT, int K, int dst_row0, const float* kscale, LAS float* scr, int kb, int nb, int lane) {
    const int k0 = 64 * kb, n0 = 32 * nb;
    { const int kr = lane >> 3, c4 = (lane & 7) * 4;
      f32x4 v[8];
      const unsigned loff = ((unsigned)kr * (unsigned)ldw + (unsigned)c4) * 4u;
      const float* Wb = W ? W + (size_t)k0 * ldw + src_col0 + n0 : nullptr;
#pragma unroll
      for (int i = 0; i < 8; ++i) { v[i] = (f32x4){0.f, 0.f, 0.f, 0.f};
          if (W != nullptr) { v[i] = ldo<f32x4>(Wb + (size_t)(8 * i) * ldw, loff); if (kscale) v[i] = v[i] * kscale[k0 + 8 * i + kr]; } }
#pragma unroll
      for (int i = 0; i < 8; ++i) { const int kk = 8 * i + kr;
#pragma unroll
          for (int e = 0; e < 4; ++e) scr[kk * 33 + c4 + e] = v[i][e]; } }
    LDS_WAIT();
    const int c = lane & 7;
    bf16_t* WTb = WT + (size_t)(dst_row0 + n0) * K + k0;
#pragma unroll
    for (int j = 0; j < 4; ++j) { const int n = (lane >> 3) + 8 * j; const LAS float* s = scr + (8 * c) * 33 + n;
        u32x4 o; o.x = pk2(s[0 * 33], s[1 * 33]); o.y = pk2(s[2 * 33], s[3 * 33]); o.z = pk2(s[4 * 33], s[5 * 33]); o.w = pk2(s[6 * 33], s[7 * 33]);
        sto<u32x4>(WTb, ((unsigned)n * (unsigned)K + 8u * (unsigned)c) * 2u, o); }
    LDS_WAIT();
}
constexpr int ITEMS_PER_LAYER = 4608;
__device__ __forceinline__ void p0_weight_item(const Args& A, int l, int r, LAS float* scr, int lane) {
    unsigned char* wb = A.ws + WS_WB;
    const float* w_in = A.in[7] + (size_t)l * 1024 * DIN; const float* ng = A.in[6] + l * 1024;
    bf16_t* W1 = (bf16_t*)(wb + WB_W1); bf16_t* W2 = (bf16_t*)(wb + WB_W2);
    if (r < 768) { transpose_item(w_in, DIN, 2176, W1, 1024, 0, ng, scr, r / 48, r % 48, lane); return; } r -= 768;
    if (r < 512) { transpose_item(w_in, DIN, 4736, W1, 1024, 1536, ng, scr, r / 32, r % 32, lane); return; } r -= 512;
    if (r < 832) { transpose_item(w_in, DIN, 0, W2, 1024, 0, ng, scr, r / 52, r % 52, lane); return; } r -= 832;
    if (r < 16) { transpose_item(l > 0 ? A.in[13] + (size_t)(l - 1) * 1024 * 32 : nullptr, 32, 0, W2, 1024, 1664, ng, scr, r, 0, lane); return; } r -= 16;
    if (r < 48) { transpose_item(nullptr, 0, 0, W2, 1024, 1696, nullptr, scr, r / 3, r % 3, lane); return; } r -= 48;
    if (r < 256) { transpose_item(w_in, DIN, 1664, W1, 1024, 2560, ng, scr, r / 16, r % 16, lane); return; } r -= 256;
    if (r < 512) { transpose_item(w_in, DIN, 3712, W2, 1024, 1792, ng, scr, r / 32, r % 32, lane); return; } r -= 512;
    if (r < 256) { transpose_item(A.in[25] + (size_t)l * 512 * 1024, 1024, 0, (bf16_t*)(wb + WB_BA), 512, 0, nullptr, scr, r / 32, r % 32, lane); return; } r -= 256;
    if (r < 256) { transpose_item(A.in[26] + (size_t)l * 512 * 1024, 1024, 0, (bf16_t*)(wb + WB_BB), 512, 0, nullptr, scr, r / 32, r % 32, lane); return; } r -= 256;
    if (r < 512) { transpose_item(A.in[27] + (size_t)l * 1024 * 1024, 1024, 0, (bf16_t*)(wb + WB_OUT), 1024, 0, nullptr, scr, r / 32, r % 32, lane); return; } r -= 512;
    if (r < 128) { transpose_item(A.in[28] + (size_t)l * 256 * 1024, 1024, 0, (bf16_t*)(wb + WB_PLE), 256, 0, nullptr, scr, r / 32, r % 32, lane); return; } r -= 128;
    transpose_item(A.in[29] + (size_t)l * 1024 * 1024, 1024, 0, (bf16_t*)(wb + ((l & 1) ? WB_GATE_ALT : WB_GATE)), 1024, 0, nullptr, scr, r / 32, r % 32, lane);
}
__device__ __forceinline__ void p0_prologue(CArgs Ap, int wv, LAS unsigned char* lds, int G) {
    const Args A = load_args(Ap);
    const int tid = opaque_tid(wv), lane = tid & 63, wave = wv;
    LAS float* scr = (LAS float*)(lds + wave * 16384);
    const int gw = blockIdx.x * 8 + wave, NGW = G * 8;
    for (int it = gw; it < ITEMS_PER_LAYER; it += NGW) p0_weight_item(A, 0, it, scr, lane);
    bf16_t* XB = (bf16_t*)(A.ws + WS_XB); float* SSQ = (float*)(A.ws + WS_SSQ);
    constexpr int XR = 4;
    for (int m0 = gw; m0 < MT; m0 += XR * NGW) {
        f32x4 v[XR][4];
#pragma unroll
        for (int b = 0; b < XR; ++b) { const int m = m0 + b * NGW;
            if (m < MR) { const f32x4* xr = (const f32x4*)(m < MP ? A.in[0] + (size_t)m * 1024 : A.in[1] + (size_t)(m - MP) * 1024) + lane;
#pragma unroll
                for (int j = 0; j < 4; ++j) v[b][j] = xr[64 * j]; }
            else {
#pragma unroll
                for (int j = 0; j < 4; ++j) v[b][j] = (f32x4){0.f, 0.f, 0.f, 0.f}; } }
#pragma unroll
        for (int b = 0; b < XR; ++b) { const int m = m0 + b * NGW;
            if (m < MT) { float s = 0.f;
#pragma unroll
                for (int j = 0; j < 4; ++j) s += dot4(v[b][j], v[b][j]);
                s = wave_sum(s);
                u32x2* o8 = (u32x2*)(XB + (size_t)m * 1024) + lane;
#pragma unroll
                for (int j = 0; j < 4; ++j) { u32x2 w; w.x = pk2(v[b][j].x, v[b][j].y); w.y = pk2(v[b][j].z, v[b][j].w); o8[64 * j] = w; }
                if (lane < 16) SSQ[(size_t)m * 16 + lane] = lane == 0 ? s : 0.f;
                if (m >= MP && m < MR) SSQ[(size_t)MT * 16 + (size_t)(m - MP) * 64 + lane] = lane == 0 ? s : 0.f; } }
    }
}
__device__ __forceinline__ void pb_convert(const Args& A, int l, int gw, int NGW, int lane) {
    bf16_t* PB = (bf16_t*)(A.ws + WS_PB);
    constexpr int PR = 5;
    for (int m0 = gw; m0 < MT; m0 += PR * NGW) { f32x4 p[PR];
#pragma unroll
        for (int b = 0; b < PR; ++b) { const int m = m0 + b * NGW; p[b] = (f32x4){0.f, 0.f, 0.f, 0.f};
            if (m < MR) p[b] = *((const f32x4*)(m < MP ? A.in[4] + ((size_t)l * MP + m) * 256 : A.in[5] + ((size_t)l * NS + (m - MP)) * 256) + lane); }
#pragma unroll
        for (int b = 0; b < PR; ++b) { const int m = m0 + b * NGW;
            if (m < MT) { u32x2 w; w.x = pk2(p[b].x, p[b].y); w.y = pk2(p[b].z, p[b].w); *((u32x2*)(PB + (size_t)m * 256) + lane) = w; } } }
}
__device__ __forceinline__ void convert_layer(const Args& A, int l, int wv, LAS unsigned char* lds, int G) {
    const int tid = opaque_tid(wv), lane = tid & 63, wave = wv;
    LAS float* scr = (LAS float*)(lds + wave * 16384);
    const int gw = blockIdx.x * 8 + wave, NGW = G * 8;
    for (int it = gw; it < ITEMS_PER_LAYER; it += NGW) p0_weight_item(A, l, it, scr, lane);
    pb_convert(A, l, gw, NGW, lane);
}

typedef float f32x16 __attribute__((ext_vector_type(16)));
constexpr int VNP = 136;
constexpr int MIX_WM = 0, MIX_ST = 34816, MIX_SV = 36864, MIX_VNT = MIX_SV + 34816, MIX_SM = MIX_SV, SMP = 132;
__device__ __forceinline__ void mix_phase(CArgs Ap, int wv, int l, LAS unsigned char* lds, int G, int dry = 0) {
    const Args A = load_args(Ap);
    const int tid = opaque_tid(wv), lane = tid & 63, wave = __builtin_amdgcn_readfirstlane(tid >> 6);
    bf16_t* U = (bf16_t*)(A.ws + G_U); const bf16_t* VB = (const bf16_t*)(A.ws + G_VB); const bf16_t* GB = (const bf16_t*)(A.ws + G_GB); bf16_t* UO = dry ? (bf16_t*)(A.ws + WS_BRB) : U;
    const float* lng = A.in[21] + l * 512; const float* lnb = A.in[22] + l * 512;
    const float* Wsp = A.in[23] + (size_t)l * 4 * 128 * 128; const float* bsp = A.in[24] + (size_t)l * 4 * 128;
    float* cv = A.out + O_CV + (size_t)l * NS * 512; const float* LNS = (const float*)(A.ws + WS_LNS);
    LAS bf16_t* WM = (LAS bf16_t*)(lds + MIX_WM); LAS bf16_t* VNt = (LAS bf16_t*)(lds + MIX_VNT); LAS unsigned char* SV = lds + MIX_SV; LAS float* SM = (LAS float*)(lds + MIX_SM);
    LAS float* ST = (LAS float*)(lds + MIX_ST);
    const int tid_phase = tid;
    int gcur = -1;
    if (wave == 0) for (int p = blockIdx.x; p < 2 * NS; p += G) {
        const int tt = p >> 1, hb = p & 1; const unsigned off = ((unsigned)(MP + tt) * 512u + 8u * (unsigned)lane) * 2u;
        f32x4 a, b, u0, u1, q0, q1; { const u32x4 tv = ldo<u32x4>(VB, off), tu = ldo<u32x4>(U, off), tg = ldo<u32x4>(GB, off); unpack8(tv, a, b); unpack8(tu, u0, u1); unpack8(tg, q0, q1); }
        const unsigned ch = 8u * (unsigned)lane; const int g = lane >> 4;
        const f32x4 lg0 = ldo<f32x4>(lng, ch * 4), lg1 = ldo<f32x4>(lng + 4, ch * 4), lb0 = ldo<f32x4>(lnb, ch * 4), lb1 = ldo<f32x4>(lnb + 4, ch * 4);
        const float w00 = Wsp[(size_t)g * 128 * 128], b00 = bsp[g * 128];
        const float mean = wave_sum(((a[0] + a[1]) + (a[2] + a[3])) + ((b[0] + b[1]) + (b[2] + b[3]))) * (1.0f / 512.0f);
        a = a - mean; b = b - mean;
        const float rstd = __builtin_amdgcn_rsqf(wave_sum(dot4(a, a) + dot4(b, b)) * (1.0f / 512.0f) + 1e-5f);
        a = a * rstd * lg0 + lb0; b = b * rstd * lg1 + lb1;
        if ((lane >> 5) == hb) {
            sto<f32x4>(cv + (size_t)tt * 512, ch * 4, a); sto<f32x4>(cv + (size_t)tt * 512 + 4, ch * 4, b);
            sto<u32x4>(UO, off, pack8(u0 * (a * w00 + b00) * q0, u1 * (b * w00 + b00) * q1)); }
    }
    for (int unit = blockIdx.x; unit < 128 * 4; unit += G) {
        int tid = tid_phase; asm volatile("" : "+v"(tid));
        const int lane = tid & 63;
        const int cidx = unit >> 2, g = unit & 3, m0 = cidx * 128;
        const int tt4 = wave >> 1, chf = wave & 1, tl = lane & 31, hh = lane >> 5, t = 32 * tt4 + tl;
        u32x4 vbr[4], ur[4], gr[4];
        const unsigned rmo = (unsigned)(((m0 + (tid >> 4)) * 512 + g * 128 + 8 * (tid & 15)) * 2);
#pragma unroll
        for (int k = 0; k < 4; ++k) vbr[k] = ldo<u32x4>(VB + (size_t)k * 32 * 512, rmo);
#pragma unroll
        for (int k = 0; k < 4; ++k) { ur[k] = ldo<u32x4>(U + (size_t)k * 32 * 512, rmo); gr[k] = ldo<u32x4>(GB + (size_t)k * 32 * 512, rmo); }
        if (lane < 16) { const int tt = wave * 16 + lane; const f32x4* lp = (const f32x4*)(LNS + (size_t)(m0 + tt) * 16);
            const f32x4 p0 = lp[0], p1 = lp[1], p2 = lp[2], p3 = lp[3];
            const float s1 = ((p0.x + p0.z) + (p1.x + p1.z)) + ((p2.x + p2.z) + (p3.x + p3.z)), s2 = ((p0.y + p0.w) + (p1.y + p1.w)) + ((p2.y + p2.w) + (p3.y + p3.w));
            const float mean = s1 * (1.0f / 512.0f), var = fmaxf(s2 * (1.0f / 512.0f) - mean * mean, 0.f);
            ST[tt * 2] = mean; ST[tt * 2 + 1] = __builtin_amdgcn_rsqf(var + 1e-5f); }
        if (g != gcur) {
            gcur = g;
#pragma unroll
            for (int k = 0; k < 8; ++k) { const int i = tid + 512 * k, tr = i >> 5, s4 = (i & 31) * 4;
                f32x4 w = ldo<f32x4>(Wsp + (size_t)g * 128 * 128, (unsigned)i * 16u);
#pragma unroll
                for (int j = 0; j < 4; ++j) w[j] = s4 + j <= tr ? w[j] : 0.f;
                u32x2 o; o.x = pk2(w[0], w[1]); o.y = pk2(w[2], w[3]); *(LAS u32x2*)(WM + tr * VNP + s4) = o; } }
#pragma unroll
        for (int k = 0; k < 4; ++k) *(LAS u32x4*)(SV + ((tid >> 4) + 32 * k) * 272 + (tid & 15) * 16) = vbr[k];
        __syncthreads();
        { const float m0_ = ST[4 * lane], r0_ = ST[4 * lane + 1], m1_ = ST[4 * lane + 2], r1_ = ST[4 * lane + 3];
          LAS unsigned* VN32 = (LAS unsigned*)VNt;
#pragma unroll
          for (int hf = 0; hf < 2; ++hf) { const int cc = 8 * (2 * wave + hf);
              const f32x4 g0 = *(const f32x4*)(lng + g * 128 + cc), g1 = *(const f32x4*)(lng + g * 128 + cc + 4), b0 = *(const f32x4*)(lnb + g * 128 + cc), b1 = *(const f32x4*)(lnb + g * 128 + cc + 4);
              f32x4 a0, a1, c0, c1; { const u32x4 ta = *(const LAS u32x4*)(SV + (2 * lane) * 272 + cc * 2), tc = *(const LAS u32x4*)(SV + (2 * lane + 1) * 272 + cc * 2); unpack8(ta, a0, a1); unpack8(tc, c0, c1); }
              a0 = (a0 - m0_) * r0_ * g0 + b0; a1 = (a1 - m0_) * r0_ * g1 + b1; c0 = (c0 - m1_) * r1_ * g0 + b0; c1 = (c1 - m1_) * r1_ * g1 + b1;
#pragma unroll
              for (int e = 0; e < 4; ++e) { VN32[(cc + e) * (VNP / 2) + lane] = pk2(a0[e], c0[e]); VN32[(cc + 4 + e) * (VNP / 2) + lane] = pk2(a1[e], c1[e]); } } }
        __syncthreads();
        f32x16 acc[2];
#pragma unroll
        for (int i = 0; i < 16; ++i) { acc[0][i] = 0.f; acc[1][i] = 0.f; }
        const int nks = 2 * tt4 + 2;
#pragma unroll
        for (int ks = 0; ks < 8; ++ks) if (ks < nks) { const int s0 = 16 * ks + 8 * hh;
            const bf16x8 bf = *(const LAS bf16x8*)(WM + t * VNP + s0);
#pragma unroll
            for (int mi = 0; mi < 2; ++mi) { const bf16x8 af = *(const LAS bf16x8*)(VNt + (64 * chf + 32 * mi + tl) * VNP + s0);
                acc[mi] = __builtin_amdgcn_mfma_f32_32x32x16_bf16(af, bf, acc[mi], 0, 0, 0); } }
        __syncthreads();
        { const float bt = bsp[g * 128 + t];
#pragma unroll
          for (int mi = 0; mi < 2; ++mi)
#pragma unroll
              for (int rg = 0; rg < 4; ++rg) { const f32x4 v = (f32x4){acc[mi][4 * rg] + bt, acc[mi][4 * rg + 1] + bt, acc[mi][4 * rg + 2] + bt, acc[mi][4 * rg + 3] + bt};
                  *(LAS f32x4*)(SM + t * SMP + 64 * chf + 32 * mi + 8 * rg + 4 * hh) = v; } }
        __syncthreads();
#pragma unroll
        for (int k = 0; k < 4; ++k) { const int r = (tid >> 4) + 32 * k, c8 = (tid & 15) * 8;
            const f32x4 ma = *(const LAS f32x4*)(SM + r * SMP + c8), mb = *(const LAS f32x4*)(SM + r * SMP + c8 + 4);
            f32x4 u0, u1, q0, q1; unpack8(ur[k], u0, u1); unpack8(gr[k], q0, q1);
            wt16(UO + (size_t)k * 32 * 512, rmo, pack8(u0 * ma * q0, u1 * mb * q1)); }
        __syncthreads();
    }
}

constexpr int REC = 336, RECS = 384, TC = 32, NCH = SEQ / TC, BUF_FLOATS = TC * REC;
struct ScanT {
    const bf16_t *R, *K, *V, *LORA; const bf16_t* VFIRST; bf16_t* VF; bf16_t* Y; float* RKP;
    const float *mu, *w0, *wup, *a0, *aup, *vup, *vb, *kk, *ka, *rk;
    const float* sh0;
};
__device__ __forceinline__ void reduce2(float& a, float& b) {
    a += dppmov<0xB1>(a); b += dppmov<0xB1>(b); a += dppmov<0x4E>(a); b += dppmov<0x4E>(b);
    a += dppmov<0x141>(a); b += dppmov<0x141>(b); a += dppmov<0x140>(a); b += dppmov<0x140>(b);
}
struct StepIn { f32x2 w0, w1, k0, k1, a0, a1, b0, b1, r0, r1; float v; };
#define LO2(t) __builtin_shufflevector(t, t, 0, 1)
#define HI2(t) __builtin_shufflevector(t, t, 2, 3)
__device__ __forceinline__ StepIn ld_step(const LAS float* rec, int cl, int vi) {
    StepIn s; const f32x4 w = *(const LAS f32x4*)(rec + 4 * cl), k = *(const LAS f32x4*)(rec + 64 + 4 * cl), a = *(const LAS f32x4*)(rec + 128 + 4 * cl),
                          b = *(const LAS f32x4*)(rec + 192 + 4 * cl), r = *(const LAS f32x4*)(rec + 256 + 4 * cl);
    s.w0 = LO2(w); s.w1 = HI2(w); s.k0 = LO2(k); s.k1 = HI2(k); s.a0 = LO2(a); s.a1 = HI2(a); s.b0 = LO2(b); s.b1 = HI2(b); s.r0 = LO2(r); s.r1 = HI2(r);
    s.v = rec[320 + vi]; return s;
}
__device__ __forceinline__ float scan_step2(f32x2& s0, f32x2& s1, float& ypart, const StepIn& in) {
    f32x2 t = s0 * in.a0; t = s1 * in.a1 + t;
    float p = t.x + t.y, yprev = ypart;
    reduce2(p, yprev);
    const f32x2 pv = (f32x2){p, p}, vv = (f32x2){in.v, in.v};
    s0 = s0 * in.w0 + (pv * in.b0 + vv * in.k0);
    s1 = s1 * in.w1 + (pv * in.b1 + vv * in.k1);
    f32x2 q = s0 * in.r0; q = s1 * in.r1 + q;
    ypart = q.x + q.y;
    return yprev;
}

struct LoraSet { u32x4 wd[2], ad[2], vd, pwd[2], pad_[2]; };
struct ElemSet { u32x2 r[2], k[2], v[2], k2[2], vf[2], pr[2], pk[2], pv[2], pk2[2]; };
struct PrepOff { unsigned m, m2, l; };
__device__ __forceinline__ PrepOff prep_off(unsigned m, int h, int nh, int kg) {
    PrepOff o; o.m = (m * 512u + (unsigned)(h * 64 + 32 * nh + 4 * kg)) * 2u; o.m2 = (m * 512u + (unsigned)(h * 64 + 32 * (1 - nh) + 4 * kg)) * 2u; o.l = (m * 256u + (unsigned)(8 * kg)) * 2u; return o;
}
template <bool SAMPLE> __device__ __forceinline__ void load_lora(const ScanT& T, const PrepOff o, bool hasprev, LoraSet& L) {
#pragma unroll
    for (int ks = 0; ks < 2; ++ks) { L.wd[ks] = ldo<u32x4>(T.LORA, o.l + 64 * ks); L.ad[ks] = ldo<u32x4>(T.LORA, o.l + 128 + 64 * ks); }
    L.vd = ldo<u32x4>(T.LORA, o.l + 256);
    if (!SAMPLE) { const u32x4 z4 = (u32x4){0u, 0u, 0u, 0u};
#pragma unroll
        for (int ks = 0; ks < 2; ++ks) { L.pwd[ks] = z4; L.pad_[ks] = z4; }
        if (hasprev) {
#pragma unroll
            for (int ks = 0; ks < 2; ++ks) { L.pwd[ks] = ldo<u32x4>(T.LORA, o.l + 64 * ks - 512); L.pad_[ks] = ldo<u32x4>(T.LORA, o.l + 128 + 64 * ks - 512); } } }
}
template <bool SAMPLE> __device__ __forceinline__ void load_elem(const ScanT& T, const PrepOff o, bool hasprev, ElemSet& E) {
#pragma unroll
    for (int nt = 0; nt < 2; ++nt) {
        E.r[nt] = ldo<u32x2>(T.R, o.m + 32 * nt); E.k[nt] = ldo<u32x2>(T.K, o.m + 32 * nt); E.v[nt] = ldo<u32x2>(T.V, o.m + 32 * nt); E.k2[nt] = ldo<u32x2>(T.K, o.m2 + 32 * nt);
        if (T.VFIRST) E.vf[nt] = ldo<u32x2>(T.VFIRST, o.m + 32 * nt); else E.vf[nt] = (u32x2){0u, 0u}; }
    if (!SAMPLE) { const u32x2 z2 = (u32x2){0u, 0u};
#pragma unroll
        for (int nt = 0; nt < 2; ++nt) { E.pr[nt] = z2; E.pk[nt] = z2; E.pv[nt] = z2; E.pk2[nt] = z2; }
        if (hasprev) {
#pragma unroll
            for (int nt = 0; nt < 2; ++nt) { E.pr[nt] = ldo<u32x2>(T.R, o.m + 32 * nt - 1024); E.pk[nt] = ldo<u32x2>(T.K, o.m + 32 * nt - 1024); E.pv[nt] = ldo<u32x2>(T.V, o.m + 32 * nt - 1024); E.pk2[nt] = ldo<u32x2>(T.K, o.m2 + 32 * nt - 1024); } } }
}
constexpr int PAR_MUR = 0, PAR_MUK = 64, PAR_MUV = 128, PAR_W0 = 192, PAR_A0 = 256, PAR_KK = 320, PAR_KA = 384, PAR_RK = 448, PAR_VB = 512, PAR_MUWD = 576, PAR_MUAD = 640, PAR_FLOATS = 704;
__device__ __forceinline__ void par_fill(const ScanT& T, int h, LAS float* PAR, int tid) {
    for (int i = tid; i < PAR_FLOATS; i += 512) { const int f = i >> 6, c = i & 63; float v = 0.f;
        if (f == 0) v = T.mu[h * 64 + c]; else if (f == 1) v = T.mu[512 + h * 64 + c]; else if (f == 2) v = T.mu[1024 + h * 64 + c];
        else if (f == 3) v = T.w0[h * 64 + c]; else if (f == 4) v = T.a0[h * 64 + c]; else if (f == 5) v = T.kk[h * 64 + c]; else if (f == 6) v = T.ka[h * 64 + c];
        else if (f == 7) v = T.rk[h * 64 + c]; else if (f == 8) v = T.vb ? T.vb[h * 64 + c] : 0.f; else if (f == 9) v = T.mu[1536 + c]; else v = T.mu[1600 + c];
        PAR[i] = v; }
}
template <bool SAMPLE>
__device__ __forceinline__ void lora_compute(const ScanT& T, const LAS float* PAR, const LoraSet& L, unsigned shj, int kg,
                                             const bf16x8 (&wupf)[2][2], const bf16x8 (&aupf)[2][2], const bf16x8 (&vuf)[2], f32x4 (&xw)[2], f32x4 (&xa)[2], f32x4 (&xv)[2]) {
    bf16x8 Tf[2], ADf[2];
    const unsigned pl = (unsigned)(8 * kg) * 4u;
#pragma unroll
    for (int ks = 0; ks < 2; ++ks) {
        f32x4 c0, c1, p0, p1; unpack8(L.wd[ks], c0, c1);
        if (SAMPLE) { p0 = ldo<f32x4>(T.sh0 + 1536, shj + pl + 128 * ks); p1 = ldo<f32x4>(T.sh0 + 1536, shj + pl + 128 * ks + 16); } else unpack8(L.pwd[ks], p0, p1);
        c0 = c0 + (p0 - c0) * *(const LAS f32x4*)(PAR + PAR_MUWD + 32 * ks + 8 * kg); c1 = c1 + (p1 - c1) * *(const LAS f32x4*)(PAR + PAR_MUWD + 32 * ks + 8 * kg + 4);
#pragma unroll
        for (int j = 0; j < 4; ++j) { c0[j] = tanhf_(c0[j]); c1[j] = tanhf_(c1[j]); }
        Tf[ks] = pack_bf8(c0, c1);
        unpack8(L.ad[ks], c0, c1);
        if (SAMPLE) { p0 = ldo<f32x4>(T.sh0 + 1600, shj + pl + 128 * ks); p1 = ldo<f32x4>(T.sh0 + 1600, shj + pl + 128 * ks + 16); } else unpack8(L.pad_[ks], p0, p1);
        c0 = c0 + (p0 - c0) * *(const LAS f32x4*)(PAR + PAR_MUAD + 32 * ks + 8 * kg); c1 = c1 + (p1 - c1) * *(const LAS f32x4*)(PAR + PAR_MUAD + 32 * ks + 8 * kg + 4);
        ADf[ks] = pack_bf8(c0, c1); }
    const bf16x8 VDf = __builtin_bit_cast(bf16x8, L.vd);
#pragma unroll
    for (int nt = 0; nt < 2; ++nt) { const f32x4 z = (f32x4){0.f, 0.f, 0.f, 0.f};
        xw[nt] = __builtin_amdgcn_mfma_f32_16x16x32_bf16(wupf[nt][0], Tf[0], z, 0, 0, 0); xw[nt] = __builtin_amdgcn_mfma_f32_16x16x32_bf16(wupf[nt][1], Tf[1], xw[nt], 0, 0, 0);
        xa[nt] = __builtin_amdgcn_mfma_f32_16x16x32_bf16(aupf[nt][0], ADf[0], z, 0, 0, 0); xa[nt] = __builtin_amdgcn_mfma_f32_16x16x32_bf16(aupf[nt][1], ADf[1], xa[nt], 0, 0, 0);
        xv[nt] = __builtin_amdgcn_mfma_f32_16x16x32_bf16(vuf[nt], VDf, z, 0, 0, 0); }
}
template <bool SAMPLE>
__device__ __forceinline__ void elem_compute(const ScanT& T, const LAS float* PAR, const ElemSet& E, const f32x4 (&xw)[2], const f32x4 (&xa)[2], const f32x4 (&xv)[2], const PrepOff o, unsigned m, unsigned shj,
                                             int h, int nh, int kg, bool wq, int v16base, LAS float* rec, bool recvalid) {
    f32x4 av[2], kkr[2]; float ssq = 0.f, rkp = 0.f;
    const unsigned pc = (unsigned)(h * 64 + 32 * nh + 4 * kg) * 4u, pc2 = (unsigned)(h * 64 + 32 * (1 - nh) + 4 * kg) * 4u;
#pragma unroll
    for (int nt = 0; nt < 2; ++nt) { const int chl = 32 * nh + 16 * nt + 4 * kg, chl2 = 32 * (1 - nh) + 16 * nt + 4 * kg;
        const f32x4 r0 = up4(E.r[nt]), k0 = up4(E.k[nt]), v0 = up4(E.v[nt]), k2 = up4(E.k2[nt]);
        f32x4 rp, kpv, vp, k2p;
        if (SAMPLE) { rp = ldo<f32x4>(T.sh0, shj + pc + 64 * nt); kpv = ldo<f32x4>(T.sh0 + 512, shj + pc + 64 * nt); vp = ldo<f32x4>(T.sh0 + 1024, shj + pc + 64 * nt); k2p = ldo<f32x4>(T.sh0 + 512, shj + pc2 + 64 * nt); }
        else { rp = up4(E.pr[nt]); kpv = up4(E.pk[nt]); vp = up4(E.pv[nt]); k2p = up4(E.pk2[nt]); }
        const f32x4 zsr = r0 + (rp - r0) * *(const LAS f32x4*)(PAR + PAR_MUR + chl), zsk = k0 + (kpv - k0) * *(const LAS f32x4*)(PAR + PAR_MUK + chl), zsv = v0 + (vp - v0) * *(const LAS f32x4*)(PAR + PAR_MUV + chl);
        const f32x4 w0v = *(const LAS f32x4*)(PAR + PAR_W0 + chl), a0v = *(const LAS f32x4*)(PAR + PAR_A0 + chl), kkv = *(const LAS f32x4*)(PAR + PAR_KK + chl), kav = *(const LAS f32x4*)(PAR + PAR_KA + chl), rkv = *(const LAS f32x4*)(PAR + PAR_RK + chl);
        f32x4 vfin = zsv;
        if (T.vup) { const f32x4 vbv = *(const LAS f32x4*)(PAR + PAR_VB + chl), vf = up4(E.vf[nt]);
#pragma unroll
            for (int e = 0; e < 4; ++e) vfin[e] = zsv[e] + (vf[e] - zsv[e]) * sigmoidf_(vbv[e] + xv[nt][e]); }
        if (wq) { u32x2 w; w.x = pk2(vfin[0], vfin[1]); w.y = pk2(vfin[2], vfin[3]); sto<u32x2>(T.VF, o.m + 32 * nt, w); }
        f32x4 dec, kp;
#pragma unroll
        for (int e = 0; e < 4; ++e) {
            const float sg = sigmoidf_(w0v[e] + xw[nt][e]); dec[e] = fexp(-0.60653065971f * sg);
            const float a = sigmoidf_(a0v[e] + xa[nt][e]); av[nt][e] = a;
            const float kr = zsk[e] * kkv[e]; kkr[nt][e] = kr; ssq += kr * kr;
            const float kq = zsk[e] * (1.0f + (a - 1.0f) * kav[e]); kp[e] = kq;
            rkp += zsr[e] * kq * rkv[e]; }
        const f32x4 zk2 = (k2 + (k2p - k2) * *(const LAS f32x4*)(PAR + PAR_MUK + chl2)) * *(const LAS f32x4*)(PAR + PAR_KK + chl2);
        ssq += dot4(zk2, zk2);
        if (recvalid) {
            *(LAS f32x4*)(rec + chl) = dec; *(LAS f32x4*)(rec + 64 + chl) = kp; *(LAS f32x4*)(rec + 256 + chl) = zsr;
            if (SAMPLE) *(LAS f32x4*)(rec + 320 + chl) = vfin;
            else if (32 * nh + 16 * nt == v16base) *(LAS f32x4*)(rec + 320 + 4 * kg) = vfin; }
    }
    ssq = xrow_sum(ssq); rkp = xrow_sum(rkp);
    const float nrm = 1.0f / fmaxf(__builtin_sqrtf(ssq), 1e-12f);
    if (wq && kg == 0) sto<float>(T.RKP, (m * 16u + (unsigned)(2 * h + nh)) * 4u, rkp);
    if (recvalid) {
#pragma unroll
        for (int nt = 0; nt < 2; ++nt) { const int chl = 32 * nh + 16 * nt + 4 * kg;
            const f32x4 kkn = kkr[nt] * nrm;
            *(LAS f32x4*)(rec + 128 + chl) = -kkn; *(LAS f32x4*)(rec + 192 + chl) = kkn * av[nt]; }
    }
}
__device__ __forceinline__ void prep_frags(const ScanT& T, int h, int nh, int lane, bf16x8 (&wupf)[2][2], bf16x8 (&aupf)[2][2], bf16x8 (&vuf)[2]) {
    const int rr = lane & 15, kg = lane >> 4;
    const unsigned voff = ((unsigned)(8 * kg) * 512u + (unsigned)(h * 64 + 32 * nh + rr)) * 4u;
#pragma unroll
    for (int nt = 0; nt < 2; ++nt) {
#pragma unroll
        for (int ks = 0; ks < 2; ++ks)
#pragma unroll
            for (int j = 0; j < 8; ++j) { const int uo = (32 * ks + j) * 512 + 16 * nt; wupf[nt][ks][j] = (short)f2bf(ldo<float>(T.wup + uo, voff)); aupf[nt][ks][j] = (short)f2bf(ldo<float>(T.aup + uo, voff)); }
        if (T.vup) {
#pragma unroll
            for (int j = 0; j < 8; ++j) vuf[nt][j] = (short)f2bf(ldo<float>(T.vup + j * 512 + 16 * nt, voff)); }
        else {
#pragma unroll
            for (int j = 0; j < 8; ++j) vuf[nt][j] = (short)0; } }
}

__device__ __forceinline__ void scan_sample_group(const Args& A, const ScanT& T, int l, int ig, LAS unsigned char* lds, int wv, int dry = 0) {
    const int tid = opaque_tid(wv); ig = opaque_s(ig);
    const int lane = tid & 63, wave = __builtin_amdgcn_readfirstlane(tid >> 6);
    const int h = ig & 7, jg = ig >> 3;
    LAS float* PAR = (LAS float*)lds;
    LAS float* BUF = PAR + PAR_FLOATS + 64;
    par_fill(T, h, PAR, tid);
    const int ii_ = wave >> 1, half_ = wave & 1, rl_ = lane >> 4, cl_ = lane & 15;
    const float* S0_ = A.in[2] + (((size_t)l * NS + (4 * jg + ii_)) * NH + h) * 4096;
    f32x4 sv[8];
#pragma unroll
    for (int rg = 0; rg < 8; ++rg) sv[rg] = *(const f32x4*)(S0_ + (32 * half_ + 4 * rg + rl_) * 64 + 4 * cl_);
    __syncthreads();
    if (wave == 4 || wave == 5) {
        const int nh = wave - 4, tokl = lane & 15, kg = lane >> 4, j = 4 * jg + (tokl & 3);
        bf16x8 wupf[2][2], aupf[2][2], vuf[2];
        prep_frags(T, h, nh, lane, wupf, aupf, vuf);
        const unsigned m = (unsigned)MP + j; const PrepOff o = prep_off(m, h, nh, kg); const unsigned shj = (unsigned)j * (unsigned)NSHIFT * 4u;
        LoraSet L; ElemSet E; load_lora<true>(T, o, false, L); load_elem<true>(T, o, false, E);
        f32x4 xw[2], xa[2], xv[2];
        lora_compute<true>(T, PAR, L, shj, kg, wupf, aupf, vuf, xw, xa, xv);
        elem_compute<true>(T, PAR, E, xw, xa, xv, o, m, shj, h, nh, kg, tokl < 4 && !dry, 0, BUF + (tokl & 3) * RECS, tokl < 4);
    }
    __syncthreads();
    {
        const int ii = wave >> 1, half = wave & 1, j = 4 * jg + ii, rl = lane >> 4, cl = lane & 15; const size_t m = (size_t)MP + j;
        const LAS float* rec = BUF + ii * RECS;
        StepIn in = ld_step(rec, cl, 0);
        float* S1 = A.out + O_WKVS + (((size_t)l * NS + j) * NH + h) * 4096;
#pragma unroll
        for (int rg = 0; rg < 8; ++rg) { const int i = 32 * half + 4 * rg + rl; in.v = rec[320 + i];
            f32x2 a0 = LO2(sv[rg]), a1 = HI2(sv[rg]); float yp = 0.f; (void)scan_step2(a0, a1, yp, in); float d = 0.f; reduce2(yp, d);
            if (!dry) { wt16(S1, (unsigned)((i * 64 + 4 * cl) * 4), __builtin_bit_cast(u32x4, (f32x4){a0.x, a0.y, a1.x, a1.y}));
            if (cl == 0) T.Y[m * 512 + h * 64 + i] = (bf16_t)f2bf(yp); } else asm volatile("" :: "v"(a0), "v"(a1), "v"(yp)); }
    }
    __syncthreads();
}


#ifndef REP_SAMPLE_DRY
#define REP_SAMPLE_DRY 0
#endif
#ifndef REP_PREP_DRY
#define REP_PREP_DRY 0
#endif
#ifndef REP_CHUNK
#define REP_CHUNK 1
#endif
#ifndef REP_PLE
#define REP_PLE 1
#endif
#ifndef REP_CHUNK_DRY
#define REP_CHUNK_DRY 0
#endif
constexpr int PK_SMALL = 4608;
__device__ __forceinline__ unsigned pk_lane_rows(int lane) { return (unsigned)((lane >> 3) * 1024 + (lane & 7) * 16); }
__device__ __forceinline__ unsigned char* pk_a1(unsigned char* ws, int tile, int h, int f) { return ws + (f < 2 ? G_R : G_K) + (size_t)tile * 16384 + (size_t)(f & 1) * 8192 + (size_t)h * 128; }
__device__ __forceinline__ unsigned char* pk_a4lo(unsigned char* ws, int tile, int h, int jt) { return ws + G_V + (size_t)tile * 16384 + (size_t)jt * 8192 + (size_t)h * 128; }
__device__ __forceinline__ unsigned char* pk_a4hi(unsigned char* ob, int tile, int h, int jt) { return ob + OS_PKA4 + (((size_t)tile * 8 + h) * 2 + (jt - 2)) * 1024; }
__device__ __forceinline__ unsigned char* pk_small(unsigned char* ws, int tile, int h) { return ws + WS_PKS + ((size_t)tile * 8 + h) * PK_SMALL; }
template <int CTRL, bool BC> __device__ __forceinline__ float dppf(float x) { return __builtin_bit_cast(float, __builtin_amdgcn_update_dpp(0, __builtin_bit_cast(int, x), CTRL, 0xf, 0xf, BC)); }
template <int CTRL, bool BC> __device__ __forceinline__ unsigned dppu(unsigned x) { return (unsigned)__builtin_amdgcn_update_dpp(0, (int)x, CTRL, 0xf, 0xf, BC); }
__device__ __forceinline__ unsigned prev_dw(unsigned cur, unsigned carry, bool first) { const unsigned p = dppu<0x121, false>(cur); return first ? carry : p; }
__device__ __forceinline__ f32x4 prod16(const f32x4 XT, const f32x4 Y) {
    f32x4 z = (f32x4){0.f, 0.f, 0.f, 0.f};
#pragma unroll
    for (int q = 0; q < 4; ++q) z = __builtin_amdgcn_mfma_f32_16x16x4f32(XT[q], Y[q], z, 0, 0, 0);
    return z;
}
__device__ __forceinline__ float nopack(float x) { asm("" : "+v"(x)); return x; }
__device__ __forceinline__ bf16x8 asbf8(const u32x4 w) { return __builtin_bit_cast(bf16x8, w); }

__device__ __forceinline__ void prep_phase(CArgs Ap, int wv, int l, LAS unsigned char* lds, int G, int dry = 0) {
    const Args A = load_args(Ap);
    const int tid = opaque_tid(wv), lane = tid & 63, tok = lane & 15, kg = lane >> 4;
    const bf16_t* R = (const bf16_t*)(A.ws + G_R); const bf16_t* K = (const bf16_t*)(A.ws + G_K); const bf16_t* V = (const bf16_t*)(A.ws + G_V); const bf16_t* LORA = (const bf16_t*)(A.ws + G_LORA);
    bf16_t* V0 = (bf16_t*)(A.ws + WS_V0); float* RKP = (float*)(A.ws + WS_RKP); const bf16_t* HALO = (const bf16_t*)(A.ws + WS_HALO);
    ScanT T; T.mu = A.in[8] + (size_t)l * NSHIFT; T.w0 = A.in[9] + l * 512; T.wup = A.in[10] + (size_t)l * 64 * 512; T.a0 = A.in[11] + l * 512; T.aup = A.in[12] + (size_t)l * 64 * 512;
    T.vup = l > 0 ? A.in[14] + (size_t)(l - 1) * 32 * 512 : nullptr; T.vb = l > 0 ? A.in[15] + (size_t)(l - 1) * 512 : nullptr;
    T.kk = A.in[16] + l * 512; T.ka = A.in[17] + l * 512; T.rk = A.in[18] + l * 512;
    const bool lay1 = l > 0;
    LAS float* PAR = (LAS float*)lds;
    LAS u32x4* FRAGS = (LAS u32x4*)(lds + 3072);
    LAS bf16_t* TR = (LAS bf16_t*)(lds + 24576 + wv * 6144);
    LAS unsigned* CAR = (LAS unsigned*)(lds + 73728 + wv * 768);
    const unsigned cl = (unsigned)(lane & 15); const bool first = tok == 0;
    for (int u = blockIdx.x; u < 256; u += G) {
        const int h = u & 7, rb = 8 * (u >> 3) + wv;
        __syncthreads();
        par_fill(T, h, PAR, tid);
        for (int f = wv; f < 20; f += 8) { const int nt = f / 5, kind = f % 5; f32x4 a = (f32x4){0.f, 0.f, 0.f, 0.f}, b = a;
            const unsigned voff = ((unsigned)(8 * kg) * 512u + (unsigned)(h * 64 + 16 * nt + tok)) * 4u;
            const float* src = kind < 2 ? T.wup + 32 * kind * 512 : (kind < 4 ? T.aup + 32 * (kind - 2) * 512 : T.vup);
            if (src != nullptr) {
#pragma unroll
                for (int j = 0; j < 4; ++j) { a[j] = ldo<float>(src + j * 512, voff); b[j] = ldo<float>(src + (4 + j) * 512, voff); } }
            FRAGS[f * 64 + lane] = pack8(a, b); }
        __syncthreads();
        { const bool seqstart = (rb & 31) == 0; const unsigned hb = (unsigned)rb * 1792u;
          if (tok == 15) {
#pragma unroll
              for (int t3 = 0; t3 < 3; ++t3)
#pragma unroll
                  for (int nt = 0; nt < 4; ++nt) { u32x2 w = (u32x2){0u, 0u}; if (!seqstart) w = ldo<u32x2>(HALO, (hb + (unsigned)(t3 * 512 + h * 64 + 16 * nt + 4 * kg)) * 2u);
                      CAR[kg * 40 + (t3 * 4 + nt) * 2] = w.x; CAR[kg * 40 + (t3 * 4 + nt) * 2 + 1] = w.y; }
#pragma unroll
              for (int wa = 0; wa < 2; ++wa)
#pragma unroll
                  for (int ks = 0; ks < 2; ++ks) { u32x4 w = (u32x4){0u, 0u, 0u, 0u}; if (!seqstart) w = ldo<u32x4>(HALO, (hb + (unsigned)(1536 + 64 * wa + 32 * ks + 8 * kg)) * 2u);
#pragma unroll
                      for (int i = 0; i < 4; ++i) CAR[kg * 40 + 24 + (wa * 2 + ks) * 4 + i] = w[i]; } }
          LDS_WAIT(); }
#pragma unroll 1
        for (int c = 0; c < 4; ++c) {
            const int m0 = 64 * rb + 16 * c, tile = m0 >> 4; const unsigned m = (unsigned)(m0 + tok);
            const unsigned om = (m * 512u + (unsigned)(h * 64 + 4 * kg)) * 2u, ol = (m * 256u + (unsigned)(8 * kg)) * 2u;
            u32x4 wd[2], ad[2], vd; u32x2 rr[4], kr_[4], vr[4], vf[4];
#pragma unroll
            for (int ks = 0; ks < 2; ++ks) { wd[ks] = ldo<u32x4>(LORA, ol + 64 * ks); ad[ks] = ldo<u32x4>(LORA, ol + 128 + 64 * ks); }
            vd = ldo<u32x4>(LORA, ol + 256);
#pragma unroll
            for (int nt = 0; nt < 4; ++nt) { rr[nt] = ldo<u32x2>(R, om + 32 * nt); kr_[nt] = ldo<u32x2>(K, om + 32 * nt); vr[nt] = ldo<u32x2>(V, om + 32 * nt);
                vf[nt] = lay1 ? ldo<u32x2>(V0, om + 32 * nt) : (u32x2){0u, 0u}; }
            u32x4 pwd[2], pad_[2]; u32x2 pr[4], pk[4], pv[4];
#pragma unroll
            for (int nt = 0; nt < 4; ++nt) {
                pr[nt].x = prev_dw(rr[nt].x, CAR[kg * 40 + (0 + nt) * 2], first); pr[nt].y = prev_dw(rr[nt].y, CAR[kg * 40 + (0 + nt) * 2 + 1], first);
                pk[nt].x = prev_dw(kr_[nt].x, CAR[kg * 40 + (4 + nt) * 2], first); pk[nt].y = prev_dw(kr_[nt].y, CAR[kg * 40 + (4 + nt) * 2 + 1], first);
                pv[nt].x = prev_dw(vr[nt].x, CAR[kg * 40 + (8 + nt) * 2], first); pv[nt].y = prev_dw(vr[nt].y, CAR[kg * 40 + (8 + nt) * 2 + 1], first); }
#pragma unroll
            for (int ks = 0; ks < 2; ++ks)
#pragma unroll
                for (int i = 0; i < 4; ++i) { pwd[ks][i] = prev_dw(wd[ks][i], CAR[kg * 40 + 24 + ks * 4 + i], first); pad_[ks][i] = prev_dw(ad[ks][i], CAR[kg * 40 + 24 + (2 + ks) * 4 + i], first); }
            LDS_WAIT();
            if (tok == 15) {
#pragma unroll
                for (int nt = 0; nt < 4; ++nt) { CAR[kg * 40 + nt * 2] = rr[nt].x; CAR[kg * 40 + nt * 2 + 1] = rr[nt].y; CAR[kg * 40 + (4 + nt) * 2] = kr_[nt].x; CAR[kg * 40 + (4 + nt) * 2 + 1] = kr_[nt].y;
                    CAR[kg * 40 + (8 + nt) * 2] = vr[nt].x; CAR[kg * 40 + (8 + nt) * 2 + 1] = vr[nt].y; }
#pragma unroll
                for (int ks = 0; ks < 2; ++ks)
#pragma unroll
                    for (int i = 0; i < 4; ++i) { CAR[kg * 40 + 24 + ks * 4 + i] = wd[ks][i]; CAR[kg * 40 + 24 + (2 + ks) * 4 + i] = ad[ks][i]; } }
            f32x4 xw[4], xa[4], xv[4];
            { bf16x8 Tf[2], ADf[2];
#pragma unroll
              for (int ks = 0; ks < 2; ++ks) { f32x4 c0, c1, p0, p1; unpack8(wd[ks], c0, c1); unpack8(pwd[ks], p0, p1);
                  c0 = c0 + (p0 - c0) * *(const LAS f32x4*)(PAR + PAR_MUWD + 32 * ks + 8 * kg); c1 = c1 + (p1 - c1) * *(const LAS f32x4*)(PAR + PAR_MUWD + 32 * ks + 8 * kg + 4);
#pragma unroll
                  for (int j = 0; j < 4; ++j) { c0[j] = tanhf_(c0[j]); c1[j] = tanhf_(c1[j]); }
                  Tf[ks] = pack_bf8(c0, c1);
                  unpack8(ad[ks], c0, c1); unpack8(pad_[ks], p0, p1);
                  c0 = c0 + (p0 - c0) * *(const LAS f32x4*)(PAR + PAR_MUAD + 32 * ks + 8 * kg); c1 = c1 + (p1 - c1) * *(const LAS f32x4*)(PAR + PAR_MUAD + 32 * ks + 8 * kg + 4);
                  ADf[ks] = pack_bf8(c0, c1); }
              const bf16x8 VDf = asbf8(vd);
#pragma unroll
              for (int nt = 0; nt < 4; ++nt) { const f32x4 z = (f32x4){0.f, 0.f, 0.f, 0.f};
                  xw[nt] = __builtin_amdgcn_mfma_f32_16x16x32_bf16(asbf8(FRAGS[(nt * 5 + 0) * 64 + lane]), Tf[0], z, 0, 0, 0); xw[nt] = __builtin_amdgcn_mfma_f32_16x16x32_bf16(asbf8(FRAGS[(nt * 5 + 1) * 64 + lane]), Tf[1], xw[nt], 0, 0, 0);
                  xa[nt] = __builtin_amdgcn_mfma_f32_16x16x32_bf16(asbf8(FRAGS[(nt * 5 + 2) * 64 + lane]), ADf[0], z, 0, 0, 0); xa[nt] = __builtin_amdgcn_mfma_f32_16x16x32_bf16(asbf8(FRAGS[(nt * 5 + 3) * 64 + lane]), ADf[1], xa[nt], 0, 0, 0);
                  xv[nt] = __builtin_amdgcn_mfma_f32_16x16x32_bf16(asbf8(FRAGS[(nt * 5 + 4) * 64 + lane]), VDf, z, 0, 0, 0); } }
            f32x4 zsk[4]; float ssq = 0.f;
#pragma unroll
            for (int nt = 0; nt < 4; ++nt) { const f32x4 k0 = up4(kr_[nt]), kp0 = up4(pk[nt]); zsk[nt] = k0 + (kp0 - k0) * *(const LAS f32x4*)(PAR + PAR_MUK + 16 * nt + 4 * kg);
                const f32x4 krw = zsk[nt] * *(const LAS f32x4*)(PAR + PAR_KK + 16 * nt + 4 * kg); ssq += dot4(krw, krw); }
            ssq = xrow_sum(ssq);
            const float nrm = 1.0f / fmaxf(__builtin_sqrtf(ssq), 1e-12f);
            u32x4 afr[2], rfr[2], bfr[2], kfr[2]; float rkp = 0.f;
            unsigned char* sm = pk_small(A.ws, tile, h);
#pragma unroll
            for (int nt = 0; nt < 4; ++nt) { const int chl = 16 * nt + 4 * kg;
                const f32x4 r0 = up4(rr[nt]), rp = up4(pr[nt]), v0 = up4(vr[nt]), vp = up4(pv[nt]);
                const f32x4 zsr = r0 + (rp - r0) * *(const LAS f32x4*)(PAR + PAR_MUR + chl), zsv = v0 + (vp - v0) * *(const LAS f32x4*)(PAR + PAR_MUV + chl);
                const f32x4 w0v = *(const LAS f32x4*)(PAR + PAR_W0 + chl), a0v = *(const LAS f32x4*)(PAR + PAR_A0 + chl), kkv = *(const LAS f32x4*)(PAR + PAR_KK + chl), kav = *(const LAS f32x4*)(PAR + PAR_KA + chl), rkv = *(const LAS f32x4*)(PAR + PAR_RK + chl);
                f32x4 vfin = zsv;
                if (lay1) { const f32x4 vbv = *(const LAS f32x4*)(PAR + PAR_VB + chl), vfv = up4(vf[nt]);
#pragma unroll
                    for (int e = 0; e < 4; ++e) vfin[e] = zsv[e] + (vfv[e] - zsv[e]) * sigmoidf_(vbv[e] + xv[nt][e]); }
                if (!dry) { u32x2 w; w.x = pk2(vfin[0], vfin[1]); w.y = pk2(vfin[2], vfin[3]); sto<u32x2>(V0, om + 32 * nt, w); }
                f32x4 at, rt, bh, kh, bB, kB, g15;
#pragma unroll
                for (int e = 0; e < 4; ++e) {
                    const float lw = -0.60653065971f * sigmoidf_(w0v[e] + xw[nt][e]);
                    const float a = sigmoidf_(a0v[e] + xa[nt][e]);
                    const float kq = zsk[nt][e] * (1.0f + (a - 1.0f) * kav[e]);
                    rkp += zsr[e] * kq * rkv[e];
                    const float kkn = zsk[nt][e] * kkv[e] * nrm, bbv = kkn * a;
                    float P = lw; P += dppf<0x111, true>(P); P += dppf<0x112, true>(P); P += dppf<0x114, true>(P); P += dppf<0x118, true>(P);
                    const float P15 = dppf<0x15F, false>(P);
                    const float g = fexp(P), gm1 = fexp(P - lw), ig = fexp(-P), gr = fexp(P15 - P);
                    at[e] = -kkn * gm1; rt[e] = zsr[e] * g; bh[e] = bbv * ig; kh[e] = kq * ig; bB[e] = bbv * gr; kB[e] = kq * gr; g15[e] = g; }
                const int ks = nt >> 1, w2 = 2 * (nt & 1);
                afr[ks][w2] = pk2(at[0], at[1]); afr[ks][w2 + 1] = pk2(at[2], at[3]); rfr[ks][w2] = pk2(rt[0], rt[1]); rfr[ks][w2 + 1] = pk2(rt[2], rt[3]);
                bfr[ks][w2] = pk2(bh[0], bh[1]); bfr[ks][w2 + 1] = pk2(bh[2], bh[3]); kfr[ks][w2] = pk2(kh[0], kh[1]); kfr[ks][w2 + 1] = pk2(kh[2], kh[3]);
#pragma unroll
                for (int e = 0; e < 4; ++e) { TR[(chl + e) * 16 + tok] = (bf16_t)f2bf(bB[e]); TR[1024 + (chl + e) * 16 + tok] = (bf16_t)f2bf(kB[e]); TR[2048 + (chl + e) * 16 + tok] = (bf16_t)f2bf(vfin[e]); }
                if (tok == 15 && !dry) sto<f32x4>(sm, (unsigned)(4096 + chl * 4), g15);
            }
            rkp = xrow_sum(rkp);
            if (kg == 0 && !dry) { sto<float>(RKP, (m * 16u + (unsigned)(2 * h)) * 4u, rkp); sto<float>(RKP, (m * 16u + (unsigned)(2 * h + 1)) * 4u, 0.f); }
            const f32x4 z4 = (f32x4){0.f, 0.f, 0.f, 0.f};
            f32x4 Nab = __builtin_amdgcn_mfma_f32_16x16x32_bf16(asbf8(bfr[0]), asbf8(afr[0]), z4, 0, 0, 0); Nab = __builtin_amdgcn_mfma_f32_16x16x32_bf16(asbf8(bfr[1]), asbf8(afr[1]), Nab, 0, 0, 0);
            f32x4 NabT = __builtin_amdgcn_mfma_f32_16x16x32_bf16(asbf8(afr[0]), asbf8(bfr[0]), z4, 0, 0, 0); NabT = __builtin_amdgcn_mfma_f32_16x16x32_bf16(asbf8(afr[1]), asbf8(bfr[1]), NabT, 0, 0, 0);
            f32x4 NakT = __builtin_amdgcn_mfma_f32_16x16x32_bf16(asbf8(afr[0]), asbf8(kfr[0]), z4, 0, 0, 0); NakT = __builtin_amdgcn_mfma_f32_16x16x32_bf16(asbf8(afr[1]), asbf8(kfr[1]), NakT, 0, 0, 0);
            f32x4 Mbr = __builtin_amdgcn_mfma_f32_16x16x32_bf16(asbf8(bfr[0]), asbf8(rfr[0]), z4, 0, 0, 0); Mbr = __builtin_amdgcn_mfma_f32_16x16x32_bf16(asbf8(bfr[1]), asbf8(rfr[1]), Mbr, 0, 0, 0);
            f32x4 Mkr = __builtin_amdgcn_mfma_f32_16x16x32_bf16(asbf8(kfr[0]), asbf8(rfr[0]), z4, 0, 0, 0); Mkr = __builtin_amdgcn_mfma_f32_16x16x32_bf16(asbf8(kfr[1]), asbf8(rfr[1]), Mkr, 0, 0, 0);
            f32x4 Idn;
#pragma unroll
            for (int q = 0; q < 4; ++q) { const unsigned row = (unsigned)(4 * kg + q);
                Nab[q] = row < cl ? Nab[q] : 0.f; NabT[q] = cl < row ? NabT[q] : 0.f; NakT[q] = cl < row ? NakT[q] : 0.f;
                Mbr[q] = row <= cl ? Mbr[q] : 0.f; Mkr[q] = row <= cl ? Mkr[q] : 0.f; Idn[q] = row == cl ? 1.f : 0.f; }
            f32x4 Tm = Idn + Nab;
            { const f32x4 P2 = prod16(NabT, Nab), P2T = prod16(Nab, NabT);
              Tm = Tm + prod16(P2T, Tm);
              const f32x4 P4 = prod16(P2T, P2), P4T = prod16(P2, P2T);
              Tm = Tm + prod16(P4T, Tm);
              const f32x4 P8T = prod16(P4, P4T);
              Tm = Tm + prod16(P8T, Tm); }
            const f32x4 NT = prod16(NakT, Tm);
            const unsigned lr = pk_lane_rows(lane);
            if (!dry) {
            wt16(pk_a1(A.ws, tile, h, 0), lr, afr[0]); wt16(pk_a1(A.ws, tile, h, 1), lr, afr[1]);
            wt16(pk_a1(A.ws, tile, h, 2), lr, rfr[0]); wt16(pk_a1(A.ws, tile, h, 3), lr, rfr[1]);
            { u32x4 w; w.x = pk2(Tm[0], Tm[1]); w.y = pk2(Tm[2], Tm[3]); w.z = pk2(NT[0], NT[1]); w.w = pk2(NT[2], NT[3]); wt16(sm, (unsigned)(lane * 16), w); }
            { u32x4 w; w.x = pk2(Mbr[0], Mbr[1]); w.y = pk2(Mbr[2], Mbr[3]); w.z = pk2(Mkr[0], Mkr[1]); w.w = pk2(Mkr[2], Mkr[3]); wt16(sm, (unsigned)(1024 + lane * 16), w); }
            LDS_WAIT();
#pragma unroll
            for (int jt = 0; jt < 4; ++jt) { const u32x2 lo = *(const LAS u32x2*)(TR + (16 * jt + tok) * 16 + 4 * kg), hi = *(const LAS u32x2*)(TR + 1024 + (16 * jt + tok) * 16 + 4 * kg);
                const u32x4 w4 = (u32x4){lo.x, lo.y, hi.x, hi.y};
                if (jt < 2) wt16(pk_a4lo(A.ws, tile, h, jt), lr, w4); else wt16(pk_a4hi((unsigned char*)A.out, tile, h, jt), (unsigned)(lane * 16), w4);
                { const u32x2 vq = *(const LAS u32x2*)(TR + 2048 + (16 * jt + tok) * 16 + 4 * kg); sto<u32x2>(sm, (unsigned)(2048 + jt * 512 + lane * 8), vq); } }
            } else asm volatile("" :: "v"(afr[0]), "v"(afr[1]), "v"(rfr[0]), "v"(rfr[1]), "v"(Tm), "v"(NT), "v"(Mbr), "v"(Mkr));
            LDS_WAIT();
        }
    }
    __syncthreads();
}

struct Pack { u32x4 a1[4], a2, a3, a4[4]; u32x2 vm; float gc; };
constexpr int RING = 14, SLOT = 11520, RING_FLAGS = RING * SLOT;
static_assert(RING_FLAGS + 64 <= 163840 - 256, "ring below the LDS control words");
__device__ __forceinline__ void glds16(const unsigned char* g, LAS unsigned char* d) { __builtin_amdgcn_global_load_lds((const unsigned*)g, (LAS unsigned*)d, 16, 0, 0); }
__device__ __forceinline__ void lds_pack_load(const LAS unsigned char* slot, unsigned va, unsigned vvm, unsigned vgc, Pack& P) {
#pragma unroll
    for (int f = 0; f < 4; ++f) { P.a1[f] = *(const LAS u32x4*)(slot + va + f * 1024); P.a4[f] = *(const LAS u32x4*)(slot + va + 4096 + f * 1024); }
    P.a2 = *(const LAS u32x4*)(slot + va + 8192); P.a3 = *(const LAS u32x4*)(slot + va + 9216);
    P.vm = *(const LAS u32x2*)(slot + vvm); P.gc = *(const LAS float*)(slot + vgc);
}
__device__ __forceinline__ void chunk_step(f32x4 (&H)[4], const Pack& P, __amdgpu_buffer_rsrc_t rs, unsigned vy, int sy, int dry = 0) {
    bf16x8 Hb[2];
#pragma unroll
    for (int ks = 0; ks < 2; ++ks) Hb[ks] = pack_bf8(H[2 * ks], H[2 * ks + 1]);
    const f32x4 z = (f32x4){0.f, 0.f, 0.f, 0.f};
    f32x4 XaT = __builtin_amdgcn_mfma_f32_16x16x32_bf16(asbf8(P.a1[0]), Hb[0], z, 0, 0, 0); XaT = __builtin_amdgcn_mfma_f32_16x16x32_bf16(asbf8(P.a1[1]), Hb[1], XaT, 0, 0, 0);
    f32x4 XrT = __builtin_amdgcn_mfma_f32_16x16x32_bf16(asbf8(P.a1[2]), Hb[0], z, 0, 0, 0); XrT = __builtin_amdgcn_mfma_f32_16x16x32_bf16(asbf8(P.a1[3]), Hb[1], XrT, 0, 0, 0);
    const u32x4 xv = (u32x4){pk2(XaT[0], XaT[1]), pk2(XaT[2], XaT[3]), P.vm.x, P.vm.y};
    const f32x4 SAT = __builtin_amdgcn_mfma_f32_16x16x32_bf16(asbf8(P.a2), asbf8(xv), z, 0, 0, 0);
    const u32x4 sv = (u32x4){pk2(SAT[0], SAT[1]), pk2(SAT[2], SAT[3]), P.vm.x, P.vm.y};
    const f32x4 YT = __builtin_amdgcn_mfma_f32_16x16x32_bf16(asbf8(P.a3), asbf8(sv), XrT, 0, 0, 0);
#pragma unroll
    for (int jt = 0; jt < 4; ++jt) { f32x4 hs;
        if (jt == 0) { hs[0] = nopack(H[0][0] * dppf<0x150, true>(P.gc)); hs[1] = nopack(H[0][1] * dppf<0x151, true>(P.gc)); hs[2] = nopack(H[0][2] * dppf<0x152, true>(P.gc)); hs[3] = nopack(H[0][3] * dppf<0x153, true>(P.gc)); }
        else if (jt == 1) { hs[0] = nopack(H[1][0] * dppf<0x154, true>(P.gc)); hs[1] = nopack(H[1][1] * dppf<0x155, true>(P.gc)); hs[2] = nopack(H[1][2] * dppf<0x156, true>(P.gc)); hs[3] = nopack(H[1][3] * dppf<0x157, true>(P.gc)); }
        else if (jt == 2) { hs[0] = nopack(H[2][0] * dppf<0x158, true>(P.gc)); hs[1] = nopack(H[2][1] * dppf<0x159, true>(P.gc)); hs[2] = nopack(H[2][2] * dppf<0x15A, true>(P.gc)); hs[3] = nopack(H[2][3] * dppf<0x15B, true>(P.gc)); }
        else { hs[0] = nopack(H[3][0] * dppf<0x15C, true>(P.gc)); hs[1] = nopack(H[3][1] * dppf<0x15D, true>(P.gc)); hs[2] = nopack(H[3][2] * dppf<0x15E, true>(P.gc)); hs[3] = nopack(H[3][3] * dppf<0x15F, true>(P.gc)); }
        H[jt] = __builtin_amdgcn_mfma_f32_16x16x32_bf16(asbf8(P.a4[jt]), asbf8(sv), hs, 0, 0, 0); }
    if (dry) { asm volatile("" :: "v"(YT)); return; }
#pragma unroll
    for (int r = 0; r < 4; ++r) __builtin_amdgcn_raw_buffer_store_b16((short)f2bf(YT[r]), rs, (int)vy + 1024 * r, sy, 0);
}
__device__ __forceinline__ void scan_chunk_block(const Args& A, int l, int bh, int qpair, int wv, LAS unsigned char* lds) {
    bh = opaque_s(bh); qpair = opaque_s(qpair);
    const int tid = opaque_tid(wv), lane = tid & 63;
    const int h = bh & 7, b = bh >> 3, tile0 = b * (SEQ / 16);
    volatile LAS unsigned* FL = (volatile LAS unsigned*)(lds + RING_FLAGS);
    constexpr int NCK = SEQ / 16;
    __syncthreads();
    if (tid < 18) FL[tid] = 0u;
    __syncthreads();
    if (wv >= 2) {
        const unsigned lr = pk_lane_rows(lane), l16 = (unsigned)lane * 16u, l4 = (unsigned)lane * 4u;
        auto issue = [&](int c) {
            if (c >= RING) { const unsigned need = (unsigned)(c - RING + 1); while (FL[16] < need || FL[17] < need) __builtin_amdgcn_s_sleep(2); }
            const int tile = tile0 + c; LAS unsigned char* slot = lds + (c % RING) * SLOT; unsigned char* ws = A.ws;
#pragma unroll
            for (int f = 0; f < 4; ++f) glds16(pk_a1(ws, tile, h, f) + lr, slot + f * 1024);
            glds16(pk_a4lo(ws, tile, h, 0) + lr, slot + 4096); glds16(pk_a4lo(ws, tile, h, 1) + lr, slot + 5120);
            glds16(pk_a4hi((unsigned char*)A.out, tile, h, 2) + l16, slot + 6144); glds16(pk_a4hi((unsigned char*)A.out, tile, h, 3) + l16, slot + 7168);
            const unsigned char* sm = pk_small(ws, tile, h);
            glds16(sm + l16, slot + 8192); glds16(sm + 1024 + l16, slot + 9216); glds16(sm + 2048 + qpair * 1024 + l16, slot + 10240);
            __builtin_amdgcn_global_load_lds((const unsigned*)(sm + 4096 + l4), (LAS unsigned*)(slot + 11264), 4, 0, 0); };
        issue(wv - 2);
        for (int c = wv - 2; c < NCK; c += 6) {
            if (c + 6 < NCK) { issue(c + 6); asm volatile("s_waitcnt vmcnt(12)" ::: "memory"); }
            else asm volatile("s_waitcnt vmcnt(0)" ::: "memory");
            FL[c % RING] = (unsigned)(c + 1);
        }
    } else {
        const int q = 2 * qpair + wv, ci = lane & 15, kg = lane >> 4;
        const __amdgpu_buffer_rsrc_t rs = __builtin_amdgcn_make_buffer_rsrc((void*)A.out, (short)0, (int)S17, 0x00020000);
        const unsigned va = (unsigned)lane * 16u, vvm = (unsigned)(10240 + wv * 512 + lane * 8), vgc = (unsigned)(11264 + (16 * ((lane & 15) >> 2) + 4 * kg + (lane & 3)) * 4), vy = (unsigned)(4 * kg * 512 + ci) * 2u;
        f32x4 H[4];
#pragma unroll
        for (int jt = 0; jt < 4; ++jt) H[jt] = (f32x4){0.f, 0.f, 0.f, 0.f};
        const int sy0 = (int)OS_Y + ((b * SEQ) * 512 + h * 64 + 16 * q) * 2;
        Pack P0, P1;
        while (FL[0] < 1u) __builtin_amdgcn_s_sleep(1);
        asm volatile("" ::: "memory");
        lds_pack_load(lds, va, vvm, vgc, P0);
        unsigned fnext = FL[1];
        int s1 = 1;
        for (int ch = 0; ch < NCK; ch += 2) {
            asm volatile("s_waitcnt lgkmcnt(0)" ::: "memory");
            FL[16 + wv] = (unsigned)(ch + 1);
            while (fnext < (unsigned)(ch + 2)) { __builtin_amdgcn_s_sleep(1); fnext = FL[s1]; }
            asm volatile("" ::: "memory");
            lds_pack_load(lds + s1 * SLOT, va, vvm, vgc, P1);
            s1 = s1 + 1 == RING ? 0 : s1 + 1;
            fnext = FL[s1];
            asm volatile("" ::: "memory");
            chunk_step(H, P0, rs, vy, sy0 + ch * 16384);
            asm volatile("s_waitcnt lgkmcnt(0)" ::: "memory");
            FL[16 + wv] = (unsigned)(ch + 2);
            if (ch + 2 < NCK) {
                while (fnext < (unsigned)(ch + 3)) { __builtin_amdgcn_s_sleep(1); fnext = FL[s1]; }
                asm volatile("" ::: "memory");
                lds_pack_load(lds + s1 * SLOT, va, vvm, vgc, P0);
                s1 = s1 + 1 == RING ? 0 : s1 + 1;
                fnext = FL[s1]; }
            asm volatile("" ::: "memory");
            chunk_step(H, P1, rs, vy, sy0 + (ch + 1) * 16384);
        }
        float* so = A.out + O_WKVP + ((((size_t)l * NB + b) * NH + h) * 64 + 16 * q + ci) * 64 + 4 * kg;
#pragma unroll
        for (int jt = 0; jt < 4; ++jt) *(f32x4*)(so + 16 * jt) = H[jt];
    }
}
__device__ __forceinline__ int ple_units_g2(int G) { const int fi = ((MT / 256) * (N2 / 256)) % G; return fi != 0 && 3 * (G - fi) >= 128 ? 128 : 0; }
template <int NCALL>
__device__ __forceinline__ void ple_units(CArgs Ap, int wv, LAS unsigned char* lds, int c, int stride, int half) {
    const Args A = load_args(Ap); c = opaque_s(c); stride = opaque_s(stride); half = opaque_s(half);
    pg8::Gemm g{(const bf16_t*)(A.ws + WS_PB) + (size_t)half * (MP / 2) * 256, (const bf16_t*)(A.ws + WS_WB + WB_PLE), MP / 2, 1024, 256};
    EpiMulAddS E{(bf16_t*)((unsigned char*)A.out + OS_PLE) + (size_t)half * (MP / 2) * 1024, nullptr, nullptr};
    { pg8::StaticOrder S; S.init(MP / 2, 1024, 1 << 20, c); pg8::gemm_phase<EpiMulAddS, pg8::StaticOrder, true, true>(lds, g, S, E, wv); }
    if (NCALL > 1) { pg8::StaticOrder S; S.init(MP / 2, 1024, 1 << 20, c + stride); pg8::gemm_phase<EpiMulAddS, pg8::StaticOrder, true, true>(lds, g, S, E, wv); }
    if (NCALL > 2) { pg8::StaticOrder S; S.init(MP / 2, 1024, 1 << 20, c + 2 * stride); pg8::gemm_phase<EpiMulAddS, pg8::StaticOrder, true, true>(lds, g, S, E, wv); }
}
__device__ __forceinline__ void ple_sample_rows(CArgs Ap, int wv, LAS unsigned char* lds, int c, int stride) {
    const Args A = load_args(Ap); c = opaque_s(c); stride = opaque_s(stride);
    const int tidm = opaque_tid(wv); bf16_t* O = (bf16_t*)((unsigned char*)A.out + OS_PLE);
    const bf16_t* Ap_ = (const bf16_t*)(A.ws + WS_PB); const bf16_t* Bp_ = (const bf16_t*)(A.ws + WS_WB + WB_PLE);
    for (int task = c; task < 128; task += stride)
        mini_gemm<256, 4>(Ap_, Bp_, lds, task, tidm, [=](int row, int col) { (void)row; (void)col; return 0; }, [=](int row, int col, f32x4 v, int) { const size_t off = (size_t)row * 1024 + col;
            u32x2 w; w.x = pk2(v[0], v[1]); w.y = pk2(v[2], v[3]); *(u32x2*)(O + off) = w; });
}
__device__ __forceinline__ void scan_phase(CArgs Ap, int wv, int l, LAS unsigned char* lds, int G, int mode = 0) {
    const Args A = load_args(Ap);
    ScanT T;
    T.R = (const bf16_t*)(A.ws + G_R); T.K = (const bf16_t*)(A.ws + G_K); T.V = (const bf16_t*)(A.ws + G_V); T.LORA = (const bf16_t*)(A.ws + G_LORA);
    T.VFIRST = l > 0 ? (const bf16_t*)(A.ws + WS_V0) : nullptr; T.VF = (bf16_t*)(A.ws + WS_V0);
    T.Y = (bf16_t*)A.out; T.RKP = (float*)(A.ws + WS_RKP);
    T.mu = A.in[8] + (size_t)l * NSHIFT; T.w0 = A.in[9] + l * 512; T.wup = A.in[10] + (size_t)l * 64 * 512; T.a0 = A.in[11] + l * 512; T.aup = A.in[12] + (size_t)l * 64 * 512;
    T.vup = l > 0 ? A.in[14] + (size_t)(l - 1) * 32 * 512 : nullptr; T.vb = l > 0 ? A.in[15] + (size_t)(l - 1) * 512 : nullptr;
    T.kk = A.in[16] + l * 512; T.ka = A.in[17] + l * 512; T.rk = A.in[18] + l * 512;
    T.sh0 = A.in[3] + (size_t)l * NS * NSHIFT;
    (void)mode;
    const int bx = opaque_s((int)blockIdx.x);
    if (G >= 2 * NB * NH + 64) {
        if (bx < 2 * NB * NH) { for (int r = 0; r < REP_CHUNK; ++r) scan_chunk_block(A, l, bx & (NB * NH - 1), bx >> 6, wv, lds); }
        else { const int NSB = G - 2 * NB * NH;
            for (int ig = bx - 2 * NB * NH; ig < (NS / 4) * NH; ig += NSB) scan_sample_group(A, T, l, ig, lds, wv);
            if (REP_SAMPLE_DRY) for (int ig = bx - 2 * NB * NH; ig < (NS / 4) * NH; ig += NSB) scan_sample_group(A, T, l, ig, lds, wv, 1); }
    } else {
        for (int ig = bx; ig < (NS / 4) * NH; ig += G) scan_sample_group(A, T, l, ig, lds, wv);
        for (int it = bx; it < 2 * NB * NH; it += G) scan_chunk_block(A, l, it & (NB * NH - 1), it >> 6, wv, lds);
    }
}

__device__ __forceinline__ void post_phase(CArgs Ap, int wv, int l, int G) {
    const Args A = load_args(Ap);
    const int tid = opaque_tid(wv); const int lane = tid & 63, wave = tid >> 6;
    const bf16_t* Y = (const bf16_t*)A.out; const bf16_t* VF = (const bf16_t*)(A.ws + WS_V0);
    const float* RKP = (const float*)(A.ws + WS_RKP); const bf16_t* GA = (const bf16_t*)(A.ws + G_GA); bf16_t* YA = (bf16_t*)(A.ws + G_R);
    const float* gg = A.in[19] + l * 512 + 8 * lane; const float* gb = A.in[20] + l * 512 + 8 * lane;
    const f32x4 g0 = *(const f32x4*)gg, g1 = *(const f32x4*)(gg + 4), b0 = *(const f32x4*)gb, b1 = *(const f32x4*)(gb + 4);
    constexpr int PR = 4;
    for (int m0 = blockIdx.x * 8 + wave; m0 < MR; m0 += PR * G * 8) {
        u32x4 ty[PR], tv[PR], tg[PR]; f32x2 rk2[PR];
#pragma unroll
        for (int b = 0; b < PR; ++b) { const int m = m0 + b * G * 8;
            if (m < MR) { ty[b] = *((const u32x4*)(Y + (size_t)m * 512) + lane); tv[b] = *((const u32x4*)(VF + (size_t)m * 512) + lane); tg[b] = *((const u32x4*)(GA + (size_t)m * 512) + lane);
                rk2[b] = *(const f32x2*)(RKP + (size_t)m * 16 + 2 * (lane >> 3)); }
            else { ty[b] = (u32x4){0u, 0u, 0u, 0u}; tv[b] = ty[b]; tg[b] = ty[b]; rk2[b] = (f32x2){0.f, 0.f}; } }
#pragma unroll
        for (int b = 0; b < PR; ++b) { const int m = m0 + b * G * 8;
            if (m < MR) {
                f32x4 y0, y1, v0, v1, ga0, ga1;
                unpack8(ty[b], y0, y1); unpack8(tv[b], v0, v1); unpack8(tg[b], ga0, ga1);
                const float rk = rk2[b].x + rk2[b].y;
                const float mean = rowsum8(((y0[0] + y0[1]) + (y0[2] + y0[3])) + ((y1[0] + y1[1]) + (y1[2] + y1[3]))) * (1.0f / 64.0f);
                y0 = y0 - mean; y1 = y1 - mean;
                const float var = rowsum8(dot4(y0, y0) + dot4(y1, y1)) * (1.0f / 64.0f);
                const float rstd = __builtin_amdgcn_rsqf(var + GN_EPS);
                const f32x4 o0 = (y0 * rstd * g0 + b0 + v0 * rk) * ga0, o1 = (y1 * rstd * g1 + b1 + v1 * rk) * ga1;
                wt16(YA, (unsigned)(((size_t)m * 512 + 8 * lane) * 2), pack8(o0, o1)); } }
    }
}

__device__ __forceinline__ void final_phase(CArgs Ap, int wv, int G) {
    const Args A = load_args(Ap);
    const int tid = opaque_tid(wv); const int lane = tid & 63, wave = tid >> 6;
    const float* ssq = (const float*)(A.ws + WS_SSQ); const float* fg = A.in[31]; const bf16_t* XB = (const bf16_t*)(A.ws + WS_XB);
    f32x4 g[4];
#pragma unroll
    for (int j = 0; j < 4; ++j) g[j] = *((const f32x4*)fg + lane + 64 * j);
    constexpr int FR = 4;
    for (int m0 = blockIdx.x * 8 + wave; m0 < MR; m0 += FR * G * 8) {
        u32x2 xv[FR][4]; float rs[FR];
#pragma unroll
        for (int b = 0; b < FR; ++b) { const int m = m0 + b * G * 8; rs[b] = 0.f;
#pragma unroll
            for (int j = 0; j < 4; ++j) xv[b][j] = (u32x2){0u, 0u};
            if (m < MR) { rs[b] = row_rstd(ssq, m); const u32x2* xr = (const u32x2*)(XB + (size_t)m * 1024) + lane;
#pragma unroll
                for (int j = 0; j < 4; ++j) xv[b][j] = xr[64 * j]; } }
#pragma unroll
        for (int b = 0; b < FR; ++b) { const int m = m0 + b * G * 8;
            if (m < MR) { f32x4* p = (f32x4*)(A.out + (size_t)m * 1024) + lane;
#pragma unroll
                for (int j = 0; j < 4; ++j) p[64 * j] = up4(xv[b][j]) * rs[b] * g[j]; } }
    }
}

#ifndef REP_SYNC
#define REP_SYNC 1
#endif
#ifndef REP_SCAN
#define REP_SCAN 1
#endif
#ifndef REP_SCAN_MODE
#define REP_SCAN_MODE 0
#endif
#ifndef REP_MIX_DRY
#define REP_MIX_DRY 0
#endif
#ifndef REP_OUT
#define REP_OUT 1
#endif
#ifndef REP_GATE
#define REP_GATE 1
#endif
#ifndef REP_MINI
#define REP_MINI 1
#endif
#ifndef REP_CONVERT
#define REP_CONVERT 1
#endif
#ifndef REP_BIG
#define REP_BIG 1
#endif
#ifndef REP_SMALL
#define REP_SMALL 1
#endif
#ifndef REP_P0
#define REP_P0 1
#endif
#ifndef REP_POST
#define REP_POST 1
#endif
#define GSYNC() do { for (int _r = 0; _r < REP_SYNC; ++_r) xcd_barrier(xbar, wv); } while (0)
constexpr int LDS_BYTES = 163840, MISC_OFF = 163840 - 256;
constexpr size_t CTL_ZERO_BYTES = 64 * KiB;
__global__ void __launch_bounds__(512, 2) fwd_kernel(Args A_unused) {
    extern __shared__ __attribute__((aligned(16))) unsigned char lds_raw[];
    LAS unsigned char* lds = (LAS unsigned char*)lds_raw;
    const int G = gridDim.x, bx = blockIdx.x, wv = __builtin_amdgcn_readfirstlane(threadIdx.x >> 6);
    const CArgs Ap = (CArgs)__builtin_amdgcn_kernarg_segment_ptr();
    volatile LAS unsigned* MISC = (volatile LAS unsigned*)(lds + MISC_OFF);
    if (threadIdx.x < 32) MISC[threadIdx.x] = 0u;
    __syncthreads();
    const XcdBarrier xbar = xcd_barrier_post((unsigned*)Ap->ws, MISC + 8);

    for (int r = 0; r < REP_P0; ++r) { p0_prologue(Ap, wv, lds, G); const Args A0 = load_args(Ap); const int t0 = opaque_tid(wv); pb_convert(A0, 0, blockIdx.x * 8 + wv, G * 8, t0 & 63); }
    GSYNC();

    for (int l = 0; l < DEPTH; ++l) {
        { const Args A = load_args(Ap); unsigned char* wb = A.ws + WS_WB; float* SSQ = (float*)(A.ws + WS_SSQ); bf16_t* XB = (bf16_t*)(A.ws + WS_XB); (void)SSQ; (void)XB;
          pg8::Gemm g{XB, (const bf16_t*)(wb + WB_W1), MP, N1, 1024}; pg8::StaticOrder S; S.init(MP, N1, G, opaque_s(bx));
          EpiG1 E{(bf16_t*)(A.ws + G_U), (bf16_t*)(A.ws + G_VB), (bf16_t*)(A.ws + G_GB), (bf16_t*)(A.ws + G_MB), (bf16_t*)(A.ws + G_GA), SSQ, (float*)(A.ws + WS_LNS)};
          for (int r = 0; r < REP_BIG; ++r) pg8::gemm_phase<EpiG1, pg8::StaticOrder, true, true>(lds, g, S, E, wv);
          const int tidm = opaque_tid(wv); bf16_t* pU = (bf16_t*)(A.ws + G_U); bf16_t* pVB = (bf16_t*)(A.ws + G_VB); bf16_t* pGB = (bf16_t*)(A.ws + G_GB); bf16_t* pMB = (bf16_t*)(A.ws + G_MB); bf16_t* pGA = (bf16_t*)(A.ws + G_GA); const float* ssqp = SSQ;
          for (int rm_ = 0; rm_ < REP_MINI; ++rm_) for (int task = opaque_s(bx); task < 8 * (N1 / 96); task += G)
              mini_gemm<1024, 6>(g.A, g.Bt, lds, task, tidm, [=](int row, int col) { (void)col; return row_rstd(ssqp, row); }, [=](int row, int col, f32x4 v, float rs) { v = v * rs;
                  bf16_t* o; if (col < 512) { for (int i = 0; i < 4; ++i) v[i] = gelu_tanh(v[i]); o = pU + (size_t)row * 512 + col; }
                  else if (col < 1024) { for (int i = 0; i < 4; ++i) v[i] = gelu_tanh(v[i]); o = pVB + (size_t)row * 512 + (col - 512); }
                  else if (col < 1536) { for (int i = 0; i < 4; ++i) v[i] = siluf_(v[i]); o = pGB + (size_t)row * 512 + (col - 1024); }
                  else if (col < 2560) { for (int i = 0; i < 4; ++i) v[i] = sigmoidf_(v[i]); o = pMB + (size_t)row * 1024 + (col - 1536); }
                  else { for (int i = 0; i < 4; ++i) v[i] = siluf_(v[i]); o = pGA + (size_t)row * 512 + (col - 2560); }
                  u32x2 w; w.x = pk2(v[0], v[1]); w.y = pk2(v[2], v[3]); *(u32x2*)o = w; }, N1 / 96); }
        GSYNC();
        mix_phase(Ap, wv, l, lds, G);
        if (REP_MIX_DRY) mix_phase(Ap, wv, l, lds, G, REP_MIX_DRY);
        GSYNC();
        { const Args A = load_args(Ap); unsigned char* wb = A.ws + WS_WB; float* SSQ = (float*)(A.ws + WS_SSQ); bf16_t* XB = (bf16_t*)(A.ws + WS_XB); (void)SSQ; (void)XB;
          pg8::Gemm g{(const bf16_t*)(A.ws + G_U), (const bf16_t*)(wb + WB_BB), MP, 1024, 512}; pg8::StaticOrder S; S.init(MP, 1024, G, opaque_s(bx));
          EpiMulAddS E{(bf16_t*)(A.ws + WS_BRB), (const bf16_t*)(A.ws + G_MB), nullptr};
          const int tidm = opaque_tid(wv); bf16_t* O = (bf16_t*)(A.ws + WS_BRB); const bf16_t* M1 = (const bf16_t*)(A.ws + G_MB);
          const int G_ = G, bx_ = opaque_s(bx);
          auto mini = [=]() { for (int rm_ = 0; rm_ < REP_MINI; ++rm_) for (int task = bx_; task < 128; task += G_)
              mini_gemm<512, 4>(g.A, g.Bt, lds + 131072, task, tidm, [=](int row, int col) { return *(const u32x2*)(M1 + (size_t)row * 1024 + col); }, [=](int row, int col, f32x4 v, u32x2 m1) { const size_t off = (size_t)row * 1024 + col; v = v * up4(m1);
                  u32x2 w; w.x = pk2(v[0], v[1]); w.y = pk2(v[2], v[3]); *(u32x2*)(O + off) = w; }); };
          for (int r = 0; r < REP_SMALL; ++r) pg8::gemm_phase<EpiMulAddS, pg8::StaticOrder, true, true>(lds, g, S, E, wv, mini); }
        GSYNC();
        { const Args A = load_args(Ap); unsigned char* wb = A.ws + WS_WB; float* SSQ = (float*)(A.ws + WS_SSQ); bf16_t* XB = (bf16_t*)(A.ws + WS_XB); (void)SSQ; (void)XB;
          pg8::Gemm g{XB, (const bf16_t*)(wb + WB_W2), MT, N2, 1024}; pg8::StaticOrder S; S.init(MT, N2, G, opaque_s(bx));
          EpiG2 E{(bf16_t*)(A.ws + G_R), (bf16_t*)(A.ws + G_K), (bf16_t*)(A.ws + G_V), (bf16_t*)(A.ws + G_LORA), (bf16_t*)(A.ws + G_MA), SSQ,
                  A.out + O_SHP + (size_t)l * NB * NSHIFT, A.out + O_SHS + (size_t)l * NS * NSHIFT, (bf16_t*)(A.ws + WS_HALO)};
          for (int r = 0; r < REP_BIG; ++r) pg8::gemm_phase<EpiG2, pg8::StaticOrder, true, true>(lds, g, S, E, wv); }
        { const int first_idle = ((MT / 256) * (N2 / 256)) % G, bxc = opaque_s(bx);
          if (ple_units_g2(G) != 0 && bxc >= first_idle) { __syncthreads(); for (int rp_ = 0; rp_ < REP_PLE; ++rp_) ple_units<3>(Ap, wv, lds, bxc - first_idle, G - first_idle, 0); } }
        GSYNC();
        prep_phase(Ap, wv, l, lds, G);
        if (REP_PREP_DRY) prep_phase(Ap, wv, l, lds, G, 1);
        GSYNC();
        for (int r = 0; r < REP_SCAN; ++r) scan_phase(Ap, wv, l, lds, G);
        { const int bxc = opaque_s(bx), nsb = G >= 2 * NB * NH + 64 ? G - 2 * NB * NH : G, cc = G >= 2 * NB * NH + 64 ? bxc - 2 * NB * NH : bxc;
          if (cc >= 0) for (int rp_ = 0; rp_ < REP_PLE; ++rp_) { __syncthreads(); if (ple_units_g2(G)) ple_units<2>(Ap, wv, lds, cc, nsb, 1); else { ple_units<3>(Ap, wv, lds, cc, nsb, 0); ple_units<3>(Ap, wv, lds, cc, nsb, 1); } __syncthreads(); ple_sample_rows(Ap, wv, lds, cc, nsb); } }
        GSYNC();
        for (int r = 0; r < REP_POST; ++r) post_phase(Ap, wv, l, G);
        GSYNC();
        { const Args A = load_args(Ap); unsigned char* wb = A.ws + WS_WB; float* SSQ = (float*)(A.ws + WS_SSQ); bf16_t* XB = (bf16_t*)(A.ws + WS_XB); (void)SSQ; (void)XB;
          pg8::Gemm g{(const bf16_t*)(A.ws + G_R), (const bf16_t*)(wb + WB_BA), MP, 1024, 512}; pg8::StaticOrder S; S.init(MP, 1024, G, opaque_s(bx));
          EpiMulAddS E{(bf16_t*)(A.ws + G_K), (const bf16_t*)(A.ws + G_MA), (const bf16_t*)(A.ws + WS_BRB)};
          const int tidm = opaque_tid(wv); bf16_t* O = (bf16_t*)(A.ws + G_K); const bf16_t* M1 = (const bf16_t*)(A.ws + G_MA); const bf16_t* AD = (const bf16_t*)(A.ws + WS_BRB);
          const int G_ = G, bx_ = opaque_s(bx);
          auto mini = [=]() {
          for (int rm_ = 0; rm_ < REP_MINI; ++rm_) for (int task = bx_; task < 128; task += G_)
              mini_gemm<512, 4>(g.A, g.Bt, lds + 131072, task, tidm, [=](int row, int col) { const size_t off = (size_t)row * 1024 + col; const u32x2 a = *(const u32x2*)(M1 + off), b = *(const u32x2*)(AD + off); return (u32x4){a.x, a.y, b.x, b.y}; },
                  [=](int row, int col, f32x4 v, u32x4 pr) { const size_t off = (size_t)row * 1024 + col; v = v * up4((u32x2){pr.x, pr.y}) + up4((u32x2){pr.z, pr.w});
                  u32x2 w; w.x = pk2(v[0], v[1]); w.y = pk2(v[2], v[3]); *(u32x2*)(O + off) = w; }); };
          for (int r = 0; r < REP_SMALL; ++r) pg8::gemm_phase<EpiMulAddS, pg8::StaticOrder, true, true>(lds, g, S, E, wv, mini); }
        GSYNC();
        { const Args A = load_args(Ap); unsigned char* wb = A.ws + WS_WB; float* SSQ = (float*)(A.ws + WS_SSQ); bf16_t* XB = (bf16_t*)(A.ws + WS_XB); (void)SSQ; (void)XB;
          pg8::Gemm g{(const bf16_t*)(A.ws + G_K), (const bf16_t*)(wb + WB_OUT), MP, 1024, 1024}; pg8::StaticOrder S; S.init(MP, 1024, G, opaque_s(bx));
          EpiOutS E{XB, (bf16_t*)(A.ws + WS_BRB)};
          const int tidm = opaque_tid(wv); bf16_t* H1B = (bf16_t*)(A.ws + WS_BRB); const bf16_t* hin = XB;
          const int G_ = G, bx_ = opaque_s(bx);
          auto mini = [=]() {
          for (int rm_ = 0; rm_ < REP_MINI; ++rm_) for (int task = bx_; task < 128; task += G_)
              mini_gemm<1024, 4>(g.A, g.Bt, lds + 131072, task, tidm, [=](int row, int col) { return *(const u32x2*)(hin + (size_t)row * 1024 + col); }, [=](int row, int col, f32x4 v, u32x2 hv) { const size_t off = (size_t)row * 1024 + col; v = v + up4(hv);
                  u32x2 w; w.x = pk2(v[0], v[1]); w.y = pk2(v[2], v[3]); *(u32x2*)(H1B + off) = w; }); };
          for (int r = 0; r < REP_OUT; ++r) pg8::gemm_phase<EpiOutS, pg8::StaticOrder, true, true>(lds, g, S, E, wv, mini); }
        GSYNC();
        { const Args A = load_args(Ap); unsigned char* wb = A.ws + WS_WB; float* SSQ = (float*)(A.ws + WS_SSQ); bf16_t* XB = (bf16_t*)(A.ws + WS_XB); (void)SSQ; (void)XB;
          pg8::Gemm g{(const bf16_t*)(A.ws + WS_BRB), (const bf16_t*)(wb + ((l & 1) ? WB_GATE_ALT : WB_GATE)), MP, 1024, 1024}; pg8::StaticOrder S; S.init(MP, 1024, G, opaque_s(bx));
          EpiGateS E{(const bf16_t*)(A.ws + WS_BRB), (const bf16_t*)((unsigned char*)A.out + OS_PLE), A.in[30] + l * 1024, XB, SSQ};
          const int tidm = opaque_tid(wv); const bf16_t* H1B = (const bf16_t*)(A.ws + WS_BRB); const bf16_t* PLE = (const bf16_t*)((unsigned char*)A.out + OS_PLE); const float* bias = A.in[30] + l * 1024; bf16_t* XBo = XB; float* ssq = SSQ;
          const int G_ = G, bx_ = opaque_s(bx);
          auto mini = [=]() {
          for (int rm_ = 0; rm_ < REP_MINI; ++rm_) for (int task = bx_; task < 128; task += G_)
              mini_gemm<1024, 4>(g.A, g.Bt, lds + 131072, task, tidm, [=](int row, int col) { const size_t off = (size_t)row * 1024 + col; const u32x2 a = *(const u32x2*)(H1B + off), b = *(const u32x2*)(PLE + off); return (u32x4){a.x, a.y, b.x, b.y}; },
                  [=](int row, int col, f32x4 v, u32x4 pr) { const size_t off = (size_t)row * 1024 + col;
                  f32x4 h = up4((u32x2){pr.x, pr.y}); const f32x4 p = up4((u32x2){pr.z, pr.w}), a = v + *(const f32x4*)(bias + col);
                  h[0] += sigmoidf_(a[0]) * p[0]; h[1] += sigmoidf_(a[1]) * p[1]; h[2] += sigmoidf_(a[2]) * p[2]; h[3] += sigmoidf_(a[3]) * p[3];
                  u32x2 w; w.x = pk2(h[0], h[1]); w.y = pk2(h[2], h[3]); *(u32x2*)(XBo + off) = w;
                  const float ss = xrow_sum((h[0] * h[0] + h[1] * h[1]) + (h[2] * h[2] + h[3] * h[3]));
                  if ((col & 15) == 0) ssq[(size_t)MT * 16 + (size_t)(row - MP) * 64 + (col >> 4)] = ss; }); };
          for (int r = 0; r < REP_GATE; ++r) pg8::gemm_phase<EpiGateS, pg8::StaticOrder, true, true>(lds, g, S, E, wv, mini);
          if (l + 1 < DEPTH) for (int rc_ = 0; rc_ < REP_CONVERT; ++rc_) convert_layer(A, l + 1, wv, lds, G);
        }
        GSYNC();
    }
    final_phase(Ap, wv, G);
}

extern "C" void kernel_launch(void* const* d_in, const int* in_sizes, int n_in, void* d_out, int out_size, void* d_ws, size_t ws_size, hipStream_t stream) {
    static int grid = 0;
    if (grid == 0) {
        int dev = 0, cus = 0, per_cu = 0;
        hipGetDevice(&dev);
        hipDeviceGetAttribute(&cus, hipDeviceAttributeMultiprocessorCount, dev);
        hipFuncSetAttribute((const void*)fwd_kernel, hipFuncAttributeMaxDynamicSharedMemorySize, LDS_BYTES);
        hipOccupancyMaxActiveBlocksPerMultiprocessor(&per_cu, (const void*)fwd_kernel, 512, LDS_BYTES);
        if (per_cu < 1) { fprintf(stderr, "kernel_launch: occupancy query says %d blocks per CU\n", per_cu); per_cu = 1; }
        grid = cus;
        if (ws_size < WS_END) { fprintf(stderr, "kernel_launch: workspace too small: %zu < %zu\n", ws_size, (size_t)WS_END); grid = -1; }
        (void)hipGetLastError();
    }
    if (grid < 0) return;
    if (hipMemsetAsync(d_ws, 0, CTL_ZERO_BYTES, stream) != hipSuccess) { fprintf(stderr, "kernel_launch: memset failed\n"); return; }
    Args a{};
    for (int i = 0; i < 32; ++i) a.in[i] = (const float*)d_in[i];
    a.out = (float*)d_out; a.ws = (unsigned char*)d_ws;
    void* args[] = {&a};
    hipError_t e = hipLaunchCooperativeKernel((const void*)fwd_kernel, dim3(grid), dim3(512), args, LDS_BYTES, stream);
    if (e != hipSuccess) fprintf(stderr, "cooperative launch failed: %s (grid %d)\n", hipGetErrorString(e), grid);
}
```

```cpp
#include <hip/hip_runtime.h>
#include <hip/hip_cooperative_groups.h>
#include <cstdio>
#include <cstdint>
namespace cg = cooperative_groups;

#define LAS __attribute__((address_space(3)))
typedef unsigned short bf16_t;
typedef short bf16x8 __attribute__((ext_vector_type(8)));
typedef float f32x4 __attribute__((ext_vector_type(4)));
typedef float f32x2 __attribute__((ext_vector_type(2)));
typedef unsigned u32x4 __attribute__((ext_vector_type(4)));
typedef unsigned u32x2 __attribute__((ext_vector_type(2)));

constexpr int DM = 1024, NB = 8, SEQ = 2048, DEPTH = 2, NS = 128;
constexpr int MP = NB * SEQ;
constexpr int MR = MP + NS;
constexpr int MT = 16640;
constexpr int DA = 512, NH = 8, DB = 512, NSHIFT = 1664, DIN = 5760, DPLE = 256;
constexpr int N1 = 3072, N2 = 2816;
constexpr float EPS = 1e-6f, GN_EPS = 64e-5f;

constexpr size_t O_YP = 0, O_YS = (size_t)MP * DM, O_WKVP = O_YS + (size_t)NS * DM, O_SHP = O_WKVP + (size_t)DEPTH * NB * NH * 4096,
                 O_WKVS = O_SHP + (size_t)DEPTH * NB * NSHIFT, O_SHS = O_WKVS + (size_t)DEPTH * NS * NH * 4096, O_CV = O_SHS + (size_t)DEPTH * NS * NSHIFT;

constexpr size_t KiB = 1024, MiB = 1024 * 1024;
constexpr size_t S17 = (size_t)MT * 512 * 2, S34 = 2 * S17, S8 = (size_t)MT * 256 * 2;
constexpr size_t WS_SSQ = 64 * KiB;
constexpr size_t WS_RKP = WS_SSQ + 1088 * KiB;
constexpr size_t WS_HALO = 2240 * KiB;
constexpr size_t WS_WB = 3200 * KiB, WB_LAYER = 18 * MiB;
constexpr size_t WB_W1 = 0, WB_W2 = WB_W1 + (size_t)N1 * 1024 * 2, WB_BA = WB_W2 + (size_t)N2 * 1024 * 2, WB_BB = WB_BA + 1024 * 512 * 2,
                 WB_OUT = WB_BB + 1024 * 512 * 2, WB_PLE = WB_OUT + 1024 * 1024 * 2, WB_GATE = WB_PLE + 1024 * 256 * 2, WB_GATE_ALT = WB_LAYER;
static_assert(WB_GATE + 1024 * 1024 * 2 == WB_LAYER, "weight map");
constexpr size_t WS_XB = WS_WB + 20 * MiB;
constexpr size_t WS_PB = WS_XB + S34;
constexpr size_t WS_V0 = WS_PB + S8;
constexpr size_t WS_BRB = WS_V0 + S17;
constexpr size_t WS_G = WS_BRB + S34;
constexpr size_t G_U = WS_G, G_VB = G_U + S17, G_GB = G_VB + S17, G_MB = G_GB + S17;
constexpr size_t G_R = WS_G, G_K = G_R + S17, G_V = G_K + S17, G_LORA = G_V + S17, G_MA = G_LORA + S8, G_GA = G_MA + S34;
constexpr size_t WS_PKS = G_GA + S17;
constexpr size_t OS_Y = 0, OS_PKA4 = S17, OS_PLE = (size_t)MR * 2048;
constexpr size_t WS_LNS = WS_PKS + (size_t)1024 * 8 * 4608;
constexpr size_t WS_END = WS_LNS + (size_t)MT * 16 * 4;
static_assert(WS_HALO + 256 * 3584 <= WS_WB && WS_RKP + (size_t)MT * 16 * 4 <= WS_HALO && WS_SSQ + (size_t)MT * 16 * 4 + NS * 64 * 4 <= WS_RKP, "small tables");
static_assert(OS_PKA4 + (size_t)1024 * 8 * 2048 <= OS_PLE && OS_PLE + (size_t)MR * 2048 <= (size_t)MR * 1024 * 4, "scratch inside the hidden-state rows of d_out");
static_assert(WS_END <= 256 * MiB, "workspace");

__device__ __forceinline__ unsigned f2bf(float f) { return (unsigned)__builtin_bit_cast(unsigned short, (__bf16)f); }
typedef __bf16 bf16x2_hw __attribute__((ext_vector_type(2)));
__device__ __forceinline__ unsigned pk2(float lo, float hi) { return __builtin_bit_cast(unsigned, __builtin_convertvector((f32x2){lo, hi}, bf16x2_hw)); }
__device__ __forceinline__ float bf_lo(unsigned w) { return __builtin_bit_cast(float, w << 16); }
__device__ __forceinline__ float bf_hi(unsigned w) { return __builtin_bit_cast(float, w & 0xffff0000u); }
__device__ __forceinline__ float bf1(bf16_t h) { return __builtin_bit_cast(float, (unsigned)h << 16); }
__device__ __forceinline__ float fexp(float x) { return __builtin_amdgcn_exp2f(x * 1.44269504089f); }
__device__ __forceinline__ float frcp(float x) { return __builtin_amdgcn_rcpf(x); }
__device__ __forceinline__ float sigmoidf_(float x) { return frcp(1.0f + fexp(-x)); }
__device__ __forceinline__ float siluf_(float x) { return x * sigmoidf_(x); }
__device__ __forceinline__ float gelu_tanh(float x) { const float u = x + 0.044715f * x * x * x; return x * frcp(1.0f + fexp(-1.5957691216f * u)); }
__device__ __forceinline__ float tanhf_(float x) { return 1.0f - 2.0f * frcp(1.0f + fexp(2.0f * x)); }
template <int CTRL> __device__ __forceinline__ float dppmov(float x) { return __builtin_bit_cast(float, __builtin_amdgcn_update_dpp(0, __builtin_bit_cast(int, x), CTRL, 0xf, 0xf, true)); }
__device__ __forceinline__ float rowsum8(float x) { x += dppmov<0xB1>(x); x += dppmov<0x4E>(x); x += dppmov<0x141>(x); return x; }
__device__ __forceinline__ float rowsum16(float x) { x = rowsum8(x); x += dppmov<0x140>(x); return x; }
__device__ __forceinline__ float xrow_sum(float v) {
    const unsigned u = __builtin_bit_cast(unsigned, v);
    auto a = __builtin_amdgcn_permlane16_swap(u, u, false, false);
    const float s = __builtin_bit_cast(float, (unsigned)a[0]) + __builtin_bit_cast(float, (unsigned)a[1]);
    const unsigned w = __builtin_bit_cast(unsigned, s);
    auto b = __builtin_amdgcn_permlane32_swap(w, w, false, false);
    return __builtin_bit_cast(float, (unsigned)b[0]) + __builtin_bit_cast(float, (unsigned)b[1]);
}
__device__ __forceinline__ float wave_sum(float v) { return xrow_sum(rowsum16(v)); }
__device__ __forceinline__ f32x4 ld4bf(const bf16_t* p) { const u32x2 w = *(const u32x2*)p; return (f32x4){bf_lo(w.x), bf_hi(w.x), bf_lo(w.y), bf_hi(w.y)}; }
__device__ __forceinline__ bf16x8 pack_bf8(const f32x4 a, const f32x4 b) { u32x4 w; w.x = pk2(a[0], a[1]); w.y = pk2(a[2], a[3]); w.z = pk2(b[0], b[1]); w.w = pk2(b[2], b[3]); return __builtin_bit_cast(bf16x8, w); }
__device__ __forceinline__ float dot4(const f32x4 a, const f32x4 b) { return (a.x * b.x + a.y * b.y) + (a.z * b.z + a.w * b.w); }
__device__ __forceinline__ f32x4 up4(const u32x2 w) { return (f32x4){bf_lo(w.x), bf_hi(w.x), bf_lo(w.y), bf_hi(w.y)}; }
#define LDS_WAIT() asm volatile("s_waitcnt lgkmcnt(0)" ::: "memory")
__device__ __forceinline__ int opaque_tid(int wv) { int ln; asm volatile("v_mbcnt_lo_u32_b32 %0, -1, 0\n\tv_mbcnt_hi_u32_b32 %0, -1, %0" : "=v"(ln)); return wv * 64 + ln; }
template <class P> __device__ __forceinline__ P* opaque_ptr(P* p) { asm volatile("" : "+s"(p)); return p; }
__device__ __forceinline__ int opaque_s(int v) { asm volatile("" : "+s"(v)); return v; }


#define XB_TMO      128
#define XB_XCNT(j)  (256  + 64 * (j))
#define XB_XSUB(j)  (1280 + 64 * (j))
#define XB_XGEN(j)  (2304 + 64 * (j))
#define XB_TOP      3328
#define XB_TOPGEN   3392
#define XCD_BAR_WORDS 3456
#define XB_SPIN_CAP (1u << 18)
__device__ __forceinline__ unsigned xb_ld(unsigned* p)              { return __hip_atomic_load(p, __ATOMIC_RELAXED, __HIP_MEMORY_SCOPE_AGENT); }
__device__ __forceinline__ unsigned xb_add(unsigned* p, unsigned v) { return __hip_atomic_fetch_add(p, v, __ATOMIC_RELAXED, __HIP_MEMORY_SCOPE_AGENT); }
__device__ __forceinline__ unsigned xb_xcc_id() { return (unsigned)__builtin_amdgcn_s_getreg((3 << 11) | 20) & 0xFu; }
#define XB_SPIN(cond, bar) do { unsigned _sp = 0; while (cond) { __builtin_amdgcn_s_sleep(1); \
    if ((++_sp & 255u) == 0u) { if (xb_ld(&(bar)[XB_TMO])) break; if (_sp > XB_SPIN_CAP) { atomicAdd(&(bar)[XB_TMO], 1u); break; } } } } while (0)
struct XcdBarrier { unsigned* bar; unsigned x; volatile LAS unsigned* st; };
__device__ __forceinline__ XcdBarrier xcd_barrier_post(unsigned* bar, volatile LAS unsigned* st) {
    XcdBarrier b; b.bar = bar; b.x = xb_xcc_id(); b.st = st;
    if (threadIdx.x == 0) (void)xb_add(&bar[XB_XCNT(b.x)], 1u);
    return b;
}
__device__ __forceinline__ void xcd_barrier_complete(unsigned* bar, unsigned x, unsigned& nloc, unsigned& nx) {
    const unsigned G = gridDim.x * gridDim.y * gridDim.z;
    unsigned sum, cnt, mine, sp = 0u;
    for (;;) {
        sum = 0u; cnt = 0u; mine = 0u;
#pragma unroll
        for (unsigned j = 0; j < 16; ++j) { const unsigned c = xb_ld(&bar[XB_XCNT(j)]); sum += c; cnt += (c > 0u) ? 1u : 0u; mine = (j == x) ? c : mine; }
        if (sum == G) break;
        __builtin_amdgcn_s_sleep(1);
        if ((++sp & 255u) == 0u) { if (xb_ld(&bar[XB_TMO])) break; if (sp > XB_SPIN_CAP) { atomicAdd(&bar[XB_TMO], 1u); break; } }
    }
    nloc = mine > 0u ? mine : 1u; nx = cnt > 0u ? cnt : 1u;
}
__device__ __forceinline__ void xcd_barrier(const XcdBarrier& b, int wv) {
    asm volatile("s_waitcnt vmcnt(0)" ::: "memory");
    __syncthreads();
    if (opaque_tid(wv) == 0) {
        unsigned* bar = b.bar;
        __builtin_amdgcn_s_waitcnt(0);
        unsigned nloc = b.st[0], nx = b.st[1];
        if (nloc == 0u) { xcd_barrier_complete(bar, b.x, nloc, nx); b.st[0] = nloc; b.st[1] = nx; }
        const unsigned old = xb_add(&bar[XB_XSUB(b.x)], 1u);
        const unsigned gen = old / nloc;
        if (old + 1u == (gen + 1u) * nloc) {
            __builtin_amdgcn_fence(__ATOMIC_RELEASE, "agent");
            asm volatile("s_waitcnt vmcnt(0)" ::: "memory");
            const unsigned og = xb_add(&bar[XB_TOP], 1u);
            const unsigned tg = og / nx;
            __builtin_amdgcn_fence(__ATOMIC_ACQUIRE, "agent");
            if (og + 1u == (tg + 1u) * nx) xb_add(&bar[XB_TOPGEN], 1u);
            else XB_SPIN(xb_ld(&bar[XB_TOPGEN]) == tg, bar);
            asm volatile("s_waitcnt vmcnt(0)" ::: "memory");
        } else {
            __builtin_amdgcn_fence(__ATOMIC_ACQUIRE, "agent");
            XB_SPIN(xb_ld(&bar[XB_TOPGEN]) == gen, bar);
            asm volatile("s_waitcnt vmcnt(0)" ::: "memory");
        }
    }
    __syncthreads();
}

namespace pg8 {
#define PG8_LAS __attribute__((address_space(3)))
constexpr int BM = 256, BK = 64, HALF = 128, HTB = HALF * BK * 2, STAGE_BYTES = 8 * HTB, NXCD = 8, WGM = 8;
__host__ __device__ __forceinline__ int lds_byte(int r, int c) { const int st = (r >> 4) * 2 + (c >> 5), rr = r & 15, cc = c & 31, ob = rr * 64 + cc * 2; return st * 1024 + (ob ^ (((ob >> 9) & 1) << 5)); }
__host__ __device__ __forceinline__ void stage_rc(int b, int& R, int& C) { const int st = b / 1024, sb = b % 1024, swz = sb ^ (((sb >> 9) & 1) << 5); R = (st >> 1) * 16 + swz / 64; C = (st & 1) * 32 + (swz % 64) / 2; }
__host__ __device__ __forceinline__ int perm32(int rho) { const int n = rho >> 4, i = rho & 15; return 8 * (i >> 2) + 4 * n + (i & 3); }
struct Unit { int pm, pn; };
struct Gemm { const bf16_t* A; const bf16_t* Bt; int M, N, K; };
struct StaticOrder {
    int nM, nN, nwg, G, c;
    __host__ __device__ void init(int M, int N, int G_, int c_) { nM = M / BM; nN = N / BM; nwg = nM * nN; G = G_; c = c_; }
    __host__ __device__ bool next(int i, Unit& u) const {
        const long L = (long)i * G + c; if (L >= nwg) return false;
        int wgid = (int)L; { const int q = nwg / NXCD, r = nwg % NXCD, xcd = wgid % NXCD, off = wgid / NXCD; wgid = (xcd < r ? xcd * (q + 1) : r * (q + 1) + (xcd - r) * q) + off; }
        const int nig = WGM * nN, gid = wgid / nig, fm = gid * WGM, gsz = (nM - fm) < WGM ? (nM - fm) : WGM;
        u.pm = fm + ((wgid % nig) % gsz); u.pn = (wgid % nig) / gsz; return true;
    }
    __device__ __forceinline__ void a_ready(const Unit&) const {}
    __device__ __forceinline__ void done(const Unit&) const {}
};

struct NoMid { __device__ __forceinline__ void operator()() const {} };
template <class Epi, class Sched, bool ALIGN_EPI = false, bool SP2 = false, class Mid = NoMid>
__device__ __forceinline__ void gemm_phase(PG8_LAS unsigned char* lds, const Gemm g, const Sched& S, const Epi& E, int wv, const Mid& mid = Mid()) {
    const int tid = opaque_tid(wv), wid = __builtin_amdgcn_readfirstlane(tid >> 6), lane = tid & 63, wr = wid >> 2, wc = wid & 3, fr = lane & 15, fq = lane >> 4;
    const int K = g.K, nt = K / BK;
    unsigned voffA[2], voffB[2];
#pragma unroll
    for (int i = 0; i < 2; ++i) { int R, C; stage_rc(tid * 16 + i * 8192, R, C); const int Rb = Epi::PERM ? ((R & ~31) + perm32(R & 31)) : R;
        voffA[i] = (unsigned)(R * K + C) * 2u; voffB[i] = (unsigned)(Rb * K + C) * 2u; }
    const size_t kstep = (size_t)(BK * 2);
    const size_t hstep = (size_t)HALF * K * 2;
    const size_t tstep = 2 * hstep;
    const unsigned ldsw = (unsigned)wid * 1024u;
    const int aoff = lds_byte(wr * 64 + fr, fq * 8), boff = lds_byte(wc * 32 + fr, fq * 8);
#define PG8_SA(b, h) (((b) * 2 + (h)) * HTB)
#define PG8_SB(b, h) ((4 + (b) * 2 + (h)) * HTB)
#define PG8_STAGE(bufoff, gbase, voff) do { _Pragma("unroll") for (int _i = 0; _i < 2; ++_i) \
        __builtin_amdgcn_global_load_lds((const unsigned*)((const char*)(gbase) + (voff)[_i]), (PG8_LAS unsigned*)(lds + (bufoff) + ldsw + _i * 8192), 16, 0, 0); } while (0)
#define PG8_LDA(dst, b, h) do { _Pragma("unroll") for (int m = 0; m < 4; ++m) _Pragma("unroll") for (int k = 0; k < 2; ++k) dst[m][k] = *(const PG8_LAS bf16x8*)(lds + PG8_SA(b, h) + aoff + m * 2048 + k * 1024); } while (0)
#define PG8_LDB(dst, b, h) do { _Pragma("unroll") for (int n = 0; n < 2; ++n) _Pragma("unroll") for (int k = 0; k < 2; ++k) dst[n][k] = *(const PG8_LAS bf16x8*)(lds + PG8_SB(b, h) + boff + n * 2048 + k * 1024); } while (0)
#define PG8_MMA(ai, bj, At, Bt) do { __builtin_amdgcn_s_setprio(1); _Pragma("unroll") for (int m = 0; m < 4; ++m) _Pragma("unroll") for (int n = 0; n < 2; ++n) _Pragma("unroll") for (int k = 0; k < 2; ++k) \
        acc[ai][bj][m][n] = __builtin_amdgcn_mfma_f32_16x16x32_bf16(Bt[n][k], At[m][k], acc[ai][bj][m][n], 0, 0, 0); __builtin_amdgcn_s_setprio(0); } while (0)
#define PG8_WAIT_V(n) asm volatile("s_waitcnt vmcnt(" #n ")" ::: "memory")
#define PG8_WAIT_L(n) asm volatile("s_waitcnt lgkmcnt(" #n ")" ::: "memory")
#define PG8_BAR __builtin_amdgcn_s_barrier()
#define PG8_SCHED __builtin_amdgcn_sched_barrier(0)
    Unit cur, nxt; int ui = 0;
    if (!S.next(0, cur)) return;
    f32x4 acc[2][2][4][2];
#pragma unroll
    for (int a = 0; a < 2; ++a)
#pragma unroll
        for (int b = 0; b < 2; ++b)
#pragma unroll
            for (int m = 0; m < 4; ++m)
#pragma unroll
                for (int n = 0; n < 2; ++n) acc[a][b][m][n] = (f32x4){0.f, 0.f, 0.f, 0.f};
    bf16x8 At[4][2], B0[2][2], B1[2][2];
    const char* cA = (const char*)g.A + (size_t)cur.pm * tstep; const char* cB = (const char*)g.Bt + (size_t)cur.pn * tstep;
    S.a_ready(cur);
    if constexpr (SP2) {
        PG8_STAGE(PG8_SB(0, 0), cB, voffB); PG8_STAGE(PG8_SB(0, 1), cB + hstep, voffB); PG8_STAGE(PG8_SA(0, 0), cA, voffA); PG8_STAGE(PG8_SA(0, 1), cA + hstep, voffA);
        mid();
        if (wr == 1) PG8_BAR;
        PG8_WAIT_V(2); PG8_BAR;
        PG8_STAGE(PG8_SB(1, 0), cB + kstep, voffB); PG8_STAGE(PG8_SA(1, 0), cA + kstep, voffA); PG8_STAGE(PG8_SB(1, 1), cB + hstep + kstep, voffB);
        PG8_WAIT_V(6); PG8_BAR;
    } else {
        PG8_STAGE(PG8_SB(0, 0), cB, voffB); PG8_STAGE(PG8_SA(0, 0), cA, voffA); PG8_STAGE(PG8_SB(0, 1), cB + hstep, voffB); PG8_STAGE(PG8_SA(0, 1), cA + hstep, voffA);
        if (wr == 1) PG8_BAR;
        PG8_WAIT_V(4); PG8_BAR;
        PG8_STAGE(PG8_SB(1, 0), cB + kstep, voffB); PG8_STAGE(PG8_SA(1, 0), cA + kstep, voffA); PG8_STAGE(PG8_SB(1, 1), cB + hstep + kstep, voffB);
        PG8_WAIT_V(6); PG8_BAR;
    }
    for (;;) {
        const bool has_next = S.next(ui + 1, nxt);
        const char* nA = has_next ? (const char*)g.A + (size_t)nxt.pm * tstep : cA; const char* nB = has_next ? (const char*)g.Bt + (size_t)nxt.pn * tstep : cB;
        for (int t = 0; t < nt; t += 2) {
            const bool last = (t == nt - 2);
            const char* a1 = cA + (size_t)(t + 1) * kstep;
            const char* a2 = last ? nA : cA + (size_t)(t + 2) * kstep; const char* b2 = last ? nB : cB + (size_t)(t + 2) * kstep;
            const char* a3 = a2 + kstep; const char* b3 = b2 + kstep;
            if (last && has_next) S.a_ready(nxt);
            if constexpr (SP2) {
            PG8_LDB(B0, 0, 0); PG8_LDB(B1, 0, 1); PG8_SCHED; PG8_LDA(At, 0, 0); PG8_STAGE(PG8_SA(1, 1), a1 + hstep, voffA);
            PG8_WAIT_V(8); PG8_WAIT_L(0); PG8_BAR; PG8_MMA(0, 0, At, B0); PG8_MMA(0, 1, At, B1); PG8_BAR; PG8_SCHED;
            PG8_LDA(At, 0, 1); PG8_STAGE(PG8_SB(0, 0), b2, voffB); PG8_STAGE(PG8_SB(0, 1), b2 + hstep, voffB); PG8_STAGE(PG8_SA(0, 0), a2, voffA);
            PG8_WAIT_V(8); PG8_WAIT_L(0); PG8_BAR; PG8_MMA(1, 0, At, B0); PG8_MMA(1, 1, At, B1); PG8_BAR; PG8_SCHED;
            PG8_LDB(B0, 1, 0); PG8_LDB(B1, 1, 1); PG8_SCHED; PG8_LDA(At, 1, 0); PG8_STAGE(PG8_SA(0, 1), a2 + hstep, voffA);
            PG8_WAIT_V(8); PG8_WAIT_L(0); PG8_BAR; PG8_MMA(0, 0, At, B0); PG8_MMA(0, 1, At, B1); PG8_BAR; PG8_SCHED;
            PG8_LDA(At, 1, 1); PG8_STAGE(PG8_SB(1, 0), b3, voffB); PG8_STAGE(PG8_SB(1, 1), b3 + hstep, voffB); PG8_STAGE(PG8_SA(1, 0), a3, voffA);
            PG8_WAIT_V(8); PG8_WAIT_L(0); PG8_BAR; PG8_MMA(1, 0, At, B0); PG8_MMA(1, 1, At, B1); PG8_BAR; PG8_SCHED;
            } else {
            PG8_LDB(B0, 0, 0); PG8_SCHED; PG8_LDA(At, 0, 0); PG8_STAGE(PG8_SA(1, 1), a1 + hstep, voffA);
            PG8_WAIT_L(8); PG8_BAR; PG8_WAIT_L(0); PG8_MMA(0, 0, At, B0); PG8_BAR; PG8_SCHED;
            PG8_LDB(B1, 0, 1); PG8_STAGE(PG8_SB(0, 0), b2, voffB);
            PG8_BAR; PG8_WAIT_L(0); PG8_MMA(0, 1, At, B1); PG8_BAR;
            PG8_LDA(At, 0, 1); PG8_STAGE(PG8_SA(0, 0), a2, voffA);
            PG8_BAR; PG8_WAIT_L(0); PG8_MMA(1, 0, At, B0); PG8_BAR; PG8_SCHED;
            PG8_STAGE(PG8_SB(0, 1), b2 + hstep, voffB);
            PG8_WAIT_V(6); PG8_BAR; PG8_MMA(1, 1, At, B1); PG8_BAR;
            PG8_LDB(B0, 1, 0); PG8_SCHED; PG8_LDA(At, 1, 0); PG8_STAGE(PG8_SA(0, 1), a2 + hstep, voffA);
            PG8_WAIT_L(8); PG8_BAR; PG8_WAIT_L(0); PG8_MMA(0, 0, At, B0); PG8_BAR; PG8_SCHED;
            PG8_LDB(B1, 1, 1); PG8_STAGE(PG8_SB(1, 0), b3, voffB);
            PG8_BAR; PG8_WAIT_L(0); PG8_MMA(0, 1, At, B1); PG8_BAR;
            PG8_LDA(At, 1, 1); PG8_STAGE(PG8_SA(1, 0), a3, voffA);
            PG8_BAR; PG8_WAIT_L(0); PG8_MMA(1, 0, At, B0); PG8_BAR; PG8_SCHED;
            PG8_STAGE(PG8_SB(1, 1), b3 + hstep, voffB);
            PG8_WAIT_V(6); PG8_BAR; PG8_MMA(1, 1, At, B1); PG8_BAR;
            }
        }
        if constexpr (ALIGN_EPI) { if (wr == 0) PG8_BAR; }
        if constexpr (!Epi::AFTER_DRAIN) { E(acc, cur, wr, wc, fr, fq); S.done(cur); }
        if (!has_next) break;
#pragma unroll
        for (int a = 0; a < 2; ++a)
#pragma unroll
            for (int b = 0; b < 2; ++b)
#pragma unroll
                for (int m = 0; m < 4; ++m)
#pragma unroll
                    for (int n = 0; n < 2; ++n) acc[a][b][m][n] = (f32x4){0.f, 0.f, 0.f, 0.f};
        cur = nxt; cA = nA; cB = nB; ++ui;
        if constexpr (ALIGN_EPI) { if (wr == 1) PG8_BAR; }
    }
    PG8_WAIT_V(0);
    if constexpr (!ALIGN_EPI) { if (wr == 0) PG8_BAR; }
    PG8_BAR;
    if constexpr (Epi::AFTER_DRAIN) { E.fused(acc, cur, wr, wc, fr, fq, lds, wid, lane); S.done(cur); }
#undef PG8_SA
#undef PG8_SB
#undef PG8_STAGE
#undef PG8_LDA
#undef PG8_LDB
#undef PG8_MMA
#undef PG8_WAIT_V
#undef PG8_WAIT_L
#undef PG8_BAR
#undef PG8_SCHED
}
}
using pg8::Unit;

__device__ __forceinline__ float row_rstd(const float* ssq, int row) {
    float s;
    if (row >= MP && row < MR) { const f32x4* p = (const f32x4*)(ssq + (size_t)MT * 16 + (size_t)(row - MP) * 64); f32x4 t = p[0];
#pragma unroll
        for (int i = 1; i < 16; ++i) t = t + p[i];
        s = (t.x + t.y) + (t.z + t.w); }
    else { const f32x4* p = (const f32x4*)(ssq + (size_t)row * 16);
        const f32x4 a = p[0], b = p[1], c = p[2], d = p[3];
        s = ((a.x + a.y) + (a.z + a.w)) + ((b.x + b.y) + (b.z + b.w)) + ((c.x + c.y) + (c.z + c.w)) + ((d.x + d.y) + (d.z + d.w)); }
    return __builtin_amdgcn_rsqf(s * (1.0f / 1024.0f) + EPS);
}
__device__ __forceinline__ float gelu_fold(float x) { constexpr float KG = -1.5957691216f * 1.44269504089f, KG3 = KG * 0.044715f; return x * frcp(1.0f + __builtin_amdgcn_exp2f(x * __builtin_fmaf(x * x, KG3, KG))); }
__device__ __forceinline__ void act8(int act, f32x4& a, f32x4& b) {
    if (act == 1) { for (int i = 0; i < 4; ++i) { a[i] = gelu_fold(a[i]); b[i] = gelu_fold(b[i]); } }
    else if (act == 2) { for (int i = 0; i < 4; ++i) { a[i] = siluf_(a[i]); b[i] = siluf_(b[i]); } }
    else if (act == 3) { for (int i = 0; i < 4; ++i) { a[i] = sigmoidf_(a[i]); b[i] = sigmoidf_(b[i]); } }
}
__device__ __forceinline__ u32x4 pack8(const f32x4& a, const f32x4& b) { u32x4 w; w.x = pk2(a[0], a[1]); w.y = pk2(a[2], a[3]); w.z = pk2(b[0], b[1]); w.w = pk2(b[2], b[3]); return w; }
__device__ __forceinline__ void wt16nt(void* base, unsigned off, const u32x4 v) { const __amdgpu_buffer_rsrc_t rs = __builtin_amdgcn_make_buffer_rsrc(base, (short)0, 0x7fffffff, 0x00020000); __builtin_amdgcn_raw_buffer_store_b128(v, rs, (int)off, 0, 18); }
__device__ __forceinline__ void wt16(void* base, unsigned off, const u32x4 v) { const __amdgpu_buffer_rsrc_t rs = __builtin_amdgcn_make_buffer_rsrc(base, (short)0, 0x7fffffff, 0x00020000); __builtin_amdgcn_raw_buffer_store_b128(v, rs, (int)off, 0, 16); }
__device__ __forceinline__ void unpack8(const u32x4& w, f32x4& a, f32x4& b) { a[0] = bf_lo(w.x); a[1] = bf_hi(w.x); a[2] = bf_lo(w.y); a[3] = bf_hi(w.y); b[0] = bf_lo(w.z); b[1] = bf_hi(w.z); b[2] = bf_lo(w.w); b[3] = bf_hi(w.w); }

struct EpiG1 {
    static constexpr bool PERM = true, AFTER_DRAIN = false;
    bf16_t *U, *VB, *GB, *MB, *GA; const float* ssq; float* lns; const LAS float* rs_lds;
    __device__ __forceinline__ void operator()(const f32x4 (&acc)[2][2][4][2], const Unit& u, int wr, int wc, int fr, int fq) const {
        const int pn = u.pn; bf16_t* base; int ldc, colt, act;
        if (pn < 2) { base = U; ldc = 512; colt = pn * 256; act = 1; }
        else if (pn < 4) { base = VB; ldc = 512; colt = (pn - 2) * 256; act = 1; }
        else if (pn < 6) { base = GB; ldc = 512; colt = (pn - 4) * 256; act = 2; }
        else if (pn < 10) { base = MB; ldc = 1024; colt = (pn - 6) * 256; act = 3; }
        else { base = GA; ldc = 512; colt = (pn - 10) * 256; act = 2; }
        const int row0 = u.pm * 256 + wr * 64 + fr, col0 = colt + wc * 32 + 8 * fq;
#pragma unroll
        for (int ai = 0; ai < 2; ++ai)
#pragma unroll
            for (int m = 0; m < 4; ++m) { const int row = row0 + ai * 128 + m * 16; const float rs = rs_lds[(u.pm & 15) * 256 + (row & 255)]; bf16_t* rowp = base + (size_t)row * ldc + col0;
                float s1 = 0.f, s2 = 0.f;
#pragma unroll
                for (int bj = 0; bj < 2; ++bj) { f32x4 v0 = acc[ai][bj][m][0] * rs, v1 = acc[ai][bj][m][1] * rs; act8(act, v0, v1); *(u32x4*)(rowp + bj * 128) = pack8(v0, v1);
                    s1 += ((v0[0] + v0[1]) + (v0[2] + v0[3])) + ((v1[0] + v1[1]) + (v1[2] + v1[3])); s2 += dot4(v0, v0) + dot4(v1, v1); }
                if (pn == 2 || pn == 3) {
                    s1 = xrow_sum(s1); s2 = xrow_sum(s2);
                    if (fq == 0) *(f32x2*)(lns + (size_t)row * 16 + ((pn - 2) * 4 + wc) * 2) = (f32x2){s1, s2}; } }
    }
};
struct EpiG2 {
    static constexpr bool PERM = true, AFTER_DRAIN = false;
    bf16_t *R, *K, *V, *LORA, *MA; const float* ssq; float* shp; float* shs; bf16_t* HALO; const LAS float* rs_lds;
    __device__ __forceinline__ void operator()(const f32x4 (&acc)[2][2][4][2], const Unit& u, int wr, int wc, int fr, int fq) const {
        const int pn = u.pn; bf16_t* base; int ldc, colt, act = 0;
        if (pn < 2) { base = R; ldc = 512; colt = pn * 256; }
        else if (pn < 4) { base = K; ldc = 512; colt = (pn - 2) * 256; }
        else if (pn < 6) { base = V; ldc = 512; colt = (pn - 4) * 256; }
        else if (pn == 6) { base = LORA; ldc = 256; colt = 0; }
        else { base = MA; ldc = 1024; colt = (pn - 7) * 256; act = 3; }
        const int row0 = u.pm * 256 + wr * 64 + fr, col0 = colt + wc * 32 + 8 * fq;
        const int ocol0 = pn * 256 + wc * 32 + 8 * fq;
#pragma unroll
        for (int ai = 0; ai < 2; ++ai)
#pragma unroll
            for (int m = 0; m < 4; ++m) { const int row = row0 + ai * 128 + m * 16; const float rs = rs_lds[(u.pm & 15) * 256 + (row & 255)]; bf16_t* rowp = base + (size_t)row * ldc + col0;
                float* sh = nullptr;
                if (pn <= 6) { if (row < MP) { if ((row & (SEQ - 1)) == SEQ - 1) sh = shp + (size_t)(row >> 11) * NSHIFT; } else if (row < MR) sh = shs + (size_t)(row - MP) * NSHIFT; }
                bf16_t* hrow = (pn <= 6 && row < MP && (row & 63) == 63 && (row >> 6) + 1 < 256) ? HALO + (size_t)((row >> 6) + 1) * 1792 + (pn < 6 ? (pn >> 1) * 512 : 1536) + col0 : nullptr;
#pragma unroll
                for (int bj = 0; bj < 2; ++bj) { f32x4 v0 = acc[ai][bj][m][0] * rs, v1 = acc[ai][bj][m][1] * rs;
                    if (sh != nullptr && (pn < 6 || bj == 0)) { float* o = sh + ocol0 + bj * 128; *(f32x4*)o = v0; *(f32x4*)(o + 4) = v1; }
                    act8(act, v0, v1); const u32x4 pk = pack8(v0, v1); *(u32x4*)(rowp + bj * 128) = pk;
                    if (hrow != nullptr && (pn < 6 || bj == 0)) *(u32x4*)(hrow + bj * 128) = pk; } }
    }
};
struct EpiMulAdd {
    static constexpr bool PERM = true, AFTER_DRAIN = false;
    bf16_t* O; const bf16_t* M1; const bf16_t* ADD;
    __device__ __forceinline__ void operator()(const f32x4 (&acc)[2][2][4][2], const Unit& u, int wr, int wc, int fr, int fq) const {
        const int row0 = u.pm * 256 + wr * 64 + fr, col0 = u.pn * 256 + wc * 32 + 8 * fq;
#pragma unroll
        for (int ai = 0; ai < 2; ++ai)
#pragma unroll
            for (int m = 0; m < 4; ++m) { const size_t off = (size_t)(row0 + ai * 128 + m * 16) * 1024 + col0;
#pragma unroll
                for (int bj = 0; bj < 2; ++bj) { f32x4 v0 = acc[ai][bj][m][0], v1 = acc[ai][bj][m][1];
                    if (M1) { f32x4 g0, g1; unpack8(*(const u32x4*)(M1 + off + bj * 128), g0, g1); v0 = v0 * g0; v1 = v1 * g1; }
                    if (ADD) { f32x4 g0, g1; unpack8(*(const u32x4*)(ADD + off + bj * 128), g0, g1); v0 = v0 + g0; v1 = v1 + g1; }
                    *(u32x4*)(O + off + bj * 128) = pack8(v0, v1); } }
    }
};
struct EpiOut {
    static constexpr bool PERM = false, AFTER_DRAIN = false;
    const float* xp; const float* xs; float* H; bf16_t* H1B; int first;
    __device__ __forceinline__ void operator()(const f32x4 (&acc)[2][2][4][2], const Unit& u, int wr, int wc, int fr, int fq) const {
        const int row0 = u.pm * 256 + wr * 64 + fr, col0 = u.pn * 256 + wc * 32 + 4 * fq;
#pragma unroll
        for (int ai = 0; ai < 2; ++ai)
#pragma unroll
            for (int m = 0; m < 4; ++m) { const int row = row0 + ai * 128 + m * 16; const bool real = row < MR;
                const float* hin = first ? (row < MP ? xp + (size_t)row * 1024 : xs + (size_t)(row - MP) * 1024) : H + (size_t)row * 1024;
#pragma unroll
                for (int bj = 0; bj < 2; ++bj)
#pragma unroll
                    for (int n = 0; n < 2; ++n) { const int c = col0 + bj * 128 + n * 16; f32x4 h = (f32x4){0.f, 0.f, 0.f, 0.f};
                        if (real) h = *(const f32x4*)(hin + c);
                        h = h + acc[ai][bj][m][n];
                        if (real) *(f32x4*)(H + (size_t)row * 1024 + c) = h;
                        u32x2 w; w.x = pk2(h[0], h[1]); w.y = pk2(h[2], h[3]); *(u32x2*)(H1B + (size_t)row * 1024 + c) = w; } }
    }
};
struct EpiGate {
    static constexpr bool PERM = false, AFTER_DRAIN = false;
    float* H; const bf16_t* PLE; const float* bias; bf16_t* XB; float* ssq;
    __device__ __forceinline__ void operator()(const f32x4 (&acc)[2][2][4][2], const Unit& u, int wr, int wc, int fr, int fq) const {
        const int row0 = u.pm * 256 + wr * 64 + fr, col0 = u.pn * 256 + wc * 32 + 4 * fq;
        f32x4 bv[2][2];
#pragma unroll
        for (int bj = 0; bj < 2; ++bj)
#pragma unroll
            for (int n = 0; n < 2; ++n) bv[bj][n] = *(const f32x4*)(bias + col0 + bj * 128 + n * 16);
#pragma unroll
        for (int ai = 0; ai < 2; ++ai)
#pragma unroll
            for (int m = 0; m < 4; ++m) { const int row = row0 + ai * 128 + m * 16; const bool real = row < MR; float ss = 0.f;
#pragma unroll
                for (int bj = 0; bj < 2; ++bj)
#pragma unroll
                    for (int n = 0; n < 2; ++n) { const int c = col0 + bj * 128 + n * 16; const size_t off = (size_t)row * 1024 + c;
                        f32x4 h = (f32x4){0.f, 0.f, 0.f, 0.f}; if (real) h = *(const f32x4*)(H + off);
                        const u32x2 pw = *(const u32x2*)(PLE + off);
                        const f32x4 a = acc[ai][bj][m][n] + bv[bj][n];
                        h[0] += sigmoidf_(a[0]) * bf_lo(pw.x); h[1] += sigmoidf_(a[1]) * bf_hi(pw.x); h[2] += sigmoidf_(a[2]) * bf_lo(pw.y); h[3] += sigmoidf_(a[3]) * bf_hi(pw.y);
                        if (real) *(f32x4*)(H + off) = h;
                        ss += (h[0] * h[0] + h[1] * h[1]) + (h[2] * h[2] + h[3] * h[3]);
                        u32x2 w; w.x = pk2(h[0], h[1]); w.y = pk2(h[2], h[3]); *(u32x2*)(XB + off) = w; }
                ss = xrow_sum(ss);
                if (fq == 0) ssq[(size_t)row * 16 + u.pn * 4 + wc] = ss; }
    }
};


struct U8 { u32x4 a, b; };
__device__ __forceinline__ float half_sum(float v) {
    const unsigned u = __builtin_bit_cast(unsigned, rowsum16(v));
    auto a = __builtin_amdgcn_permlane16_swap(u, u, false, false);
    return __builtin_bit_cast(float, (unsigned)a[0]) + __builtin_bit_cast(float, (unsigned)a[1]);
}
template <bool PERM, class Pre, class Fin>
__device__ __forceinline__ void staged_rows(const f32x4 (&acc)[2][2][4][2], const Unit& u, int wr, int wc, int fr, int fq, LAS unsigned char* lds, int wid, int lane, const Pre& pre, const Fin& fin) {
    LAS f32x4* T4 = (LAS f32x4*)lds;
    const int hl = lane >> 5, c8 = lane & 31;
#pragma unroll
    for (int ai = 0; ai < 2; ++ai) {
        decltype(pre(0, 0)) pv[8];
#pragma unroll
        for (int i = 0; i < 8; ++i) pv[i] = pre(u.pm * 256 + 128 * ai + 16 * wid + 2 * i + hl, c8);
#pragma unroll
        for (int m = 0; m < 4; ++m) { const int rl = 64 * wr + 16 * m + fr;
#pragma unroll
            for (int bj = 0; bj < 2; ++bj)
#pragma unroll
                for (int n = 0; n < 2; ++n) { const int ch = PERM ? 32 * bj + 8 * wc + 2 * fq + n : 32 * bj + 8 * wc + 4 * n + fq; T4[rl * 64 + (ch ^ (rl & 15))] = acc[ai][bj][m][n]; } }
        asm volatile("s_waitcnt lgkmcnt(0)" ::: "memory"); __builtin_amdgcn_s_barrier(); asm volatile("" ::: "memory");
#pragma unroll
        for (int i = 0; i < 8; ++i) { const int rl = 16 * wid + 2 * i + hl; const f32x4 v0 = T4[rl * 64 + ((2 * c8) ^ (rl & 15))], v1 = T4[rl * 64 + ((2 * c8 + 1) ^ (rl & 15))];
            fin(u.pm * 256 + 128 * ai + rl, c8, v0, v1, pv[i]); }
        asm volatile("s_waitcnt lgkmcnt(0)" ::: "memory"); __builtin_amdgcn_s_barrier(); asm volatile("" ::: "memory");
    }
}
struct EpiOutS {
    static constexpr bool PERM = false, AFTER_DRAIN = true;
    const bf16_t* hin; bf16_t* H1B;
    __device__ __forceinline__ void fused(const f32x4 (&acc)[2][2][4][2], const Unit& u, int wr, int wc, int fr, int fq, LAS unsigned char* lds, int wid, int lane) const {
        const bf16_t* hi = hin; bf16_t* ho = H1B; const int pn = u.pn;
        staged_rows<false>(acc, u, wr, wc, fr, fq, lds, wid, lane,
            [=](int row, int c8) { return *(const u32x4*)(hi + (size_t)row * 1024 + pn * 256 + 8 * c8); },
            [=](int row, int c8, f32x4 v0, f32x4 v1, u32x4 hv) { f32x4 h0, h1; unpack8(hv, h0, h1); wt16(ho, (unsigned)(((size_t)row * 1024 + pn * 256 + 8 * c8) * 2), pack8(h0 + v0, h1 + v1)); });
    }
};
struct EpiGateS {
    static constexpr bool PERM = false, AFTER_DRAIN = true;
    const bf16_t* H1B; const bf16_t* PLE; const float* bias; bf16_t* XB; float* ssq;
    __device__ __forceinline__ void fused(const f32x4 (&acc)[2][2][4][2], const Unit& u, int wr, int wc, int fr, int fq, LAS unsigned char* lds, int wid, int lane) const {
        const bf16_t* h1p = H1B; const bf16_t* pl = PLE; bf16_t* xb = XB; float* sq = ssq; const int pn = u.pn;
        const f32x4 bv0 = *(const f32x4*)(bias + pn * 256 + 8 * (lane & 31)), bv1 = *(const f32x4*)(bias + pn * 256 + 8 * (lane & 31) + 4);
        staged_rows<false>(acc, u, wr, wc, fr, fq, lds, wid, lane,
            [=](int row, int c8) { const size_t off = (size_t)row * 1024 + pn * 256 + 8 * c8; U8 r; r.a = *(const u32x4*)(h1p + off); r.b = *(const u32x4*)(pl + off); return r; },
            [=](int row, int c8, f32x4 v0, f32x4 v1, U8 pr) { const size_t off = (size_t)row * 1024 + pn * 256 + 8 * c8;
                f32x4 h0, h1, p0, p1; unpack8(pr.a, h0, h1); unpack8(pr.b, p0, p1); const f32x4 a0 = v0 + bv0, a1 = v1 + bv1;
#pragma unroll
                for (int e = 0; e < 4; ++e) { h0[e] += sigmoidf_(a0[e]) * p0[e]; h1[e] += sigmoidf_(a1[e]) * p1[e]; }
                wt16(xb, (unsigned)(off * 2), pack8(h0, h1));
                const float ss = half_sum(dot4(h0, h0) + dot4(h1, h1));
                if (c8 < 4) sq[(size_t)row * 16 + pn * 4 + c8] = c8 == 0 ? ss : 0.f; });
    }
};

struct EpiMulAddS {
    static constexpr bool PERM = true, AFTER_DRAIN = true;
    bf16_t* O; const bf16_t* M1; const bf16_t* ADD;
    __device__ __forceinline__ void fused(const f32x4 (&acc)[2][2][4][2], const Unit& u, int wr, int wc, int fr, int fq, LAS unsigned char* lds, int wid, int lane) const {
        bf16_t* o = O; const bf16_t* m1 = M1; const bf16_t* ad = ADD; const int pn = u.pn;
        staged_rows<true>(acc, u, wr, wc, fr, fq, lds, wid, lane,
            [=](int row, int c8) { const size_t off = (size_t)row * 1024 + pn * 256 + 8 * c8; U8 r; r.a = (u32x4){0u, 0u, 0u, 0u}; r.b = r.a;
                if (m1) r.a = *(const u32x4*)(m1 + off); if (ad) r.b = *(const u32x4*)(ad + off); return r; },
            [=](int row, int c8, f32x4 v0, f32x4 v1, U8 pr) { const size_t off = (size_t)row * 1024 + pn * 256 + 8 * c8;
                if (m1) { f32x4 g0, g1; unpack8(pr.a, g0, g1); v0 = v0 * g0; v1 = v1 * g1; } if (ad) { f32x4 g0, g1; unpack8(pr.b, g0, g1); v0 = v0 + g0; v1 = v1 + g1; }
                wt16(o, (unsigned)(off * 2), pack8(v0, v1)); });
    }
};

template <int K, int NT, class Pre, class Fin>
__device__ __forceinline__ void mini_gemm(const bf16_t* Afull, const bf16_t* Bt, LAS unsigned char* lds, int task, int tid, const Pre& pre, const Fin& fin, int ncb = 16) {
    const int wave = __builtin_amdgcn_readfirstlane(tid >> 6), lane = tid & 63, r = lane & 15, kq = lane >> 4, rb = task / ncb, cb = task % ncb;
    constexpr int kper = K >> 3, NST = kper / 32;
    const int k0 = wave * kper;
    f32x4 acc[NT];
#pragma unroll
    for (int n = 0; n < NT; ++n) acc[n] = (f32x4){0.f, 0.f, 0.f, 0.f};
    const bf16_t* ap = Afull + (size_t)(MP + 16 * rb + r) * K + k0 + 8 * kq;
    const bf16_t* bp = Bt + (size_t)(16 * NT * cb + r) * K + k0 + 8 * kq;
    bf16x8 af[NST], bfr[NST][NT];
    const int erow = MP + 16 * rb + r, ecol = 16 * NT * cb + 16 * (wave < NT ? wave : 0) + 4 * kq;
#pragma unroll
    for (int st = 0; st < NST; ++st) { af[st] = *(const bf16x8*)(ap + 32 * st);
#pragma unroll
        for (int n = 0; n < NT; ++n) bfr[st][n] = *(const bf16x8*)(bp + (size_t)(16 * n) * K + 32 * st); }
    decltype(pre(0, 0)) pv = pre(erow, ecol);
#pragma unroll
    for (int st = 0; st < NST; ++st)
#pragma unroll
        for (int n = 0; n < NT; ++n) acc[n] = __builtin_amdgcn_mfma_f32_16x16x32_bf16(bfr[st][n], af[st], acc[n], 0, 0, 0);
    LAS f32x4* red = (LAS f32x4*)lds;
#pragma unroll
    for (int n = 0; n < NT; ++n) if (wave != n) red[(n * 7 + (wave < n ? wave : wave - 1)) * 64 + lane] = acc[n];
    __syncthreads();
    if (wave < NT) { f32x4 v = acc[0];
#pragma unroll
        for (int n = 1; n < NT; ++n) v = wave == n ? acc[n] : v;
#pragma unroll
        for (int w = 0; w < 7; ++w) v = v + red[(wave * 7 + w) * 64 + lane];
        fin(erow, ecol, v, pv); }
    __syncthreads();
}

struct Args { const float* in[32]; float* out; unsigned char* ws; };
typedef const __attribute__((address_space(4))) Args* CArgs;
__device__ __forceinline__ Args load_args(CArgs p) {
    asm volatile("" : "+s"(p));
    Args a;
#pragma unroll
    for (int i = 0; i < 32; ++i) a.in[i] = p->in[i];
    a.out = p->out; a.ws = p->ws; return a;
}

template <class V> __device__ __forceinline__ V ldo(const void* base, unsigned off) { return *(const V*)((const char*)base + off); }
template <class V> __device__ __forceinline__ void sto(void* base, unsigned off, const V& v) { *(V*)((char*)base + off) = v; }
__device__ __forceinline__ void transpose_item(const float* W, int ldw, int src_col0, bf16_t* WT, int K, int dst_row0, const float* kscale, LAS float* scr, int kb, int nb, int lane) {
    const int k0 = 64 * kb, n0 = 32 * nb;
    { const int kr = lane >> 3, c4 = (lane & 7) * 4;
      f32x4 v[8];
      const unsigned loff = ((unsigned)kr * (unsigned)ldw + (unsigned)c4) * 4u;
      const float* Wb = W ? W + (size_t)k0 * ldw + src_col0 + n0 : nullptr;
#pragma unroll
      for (int i = 0; i < 8; ++i) { v[i] = (f32x4){0.f, 0.f, 0.f, 0.f};
          if (W != nullptr) { v[i] = __builtin_nontemporal_load((const f32x4*)((const char*)(Wb + (size_t)(8 * i) * ldw) + loff));
          if (kscale) v[i] = v[i] * kscale[k0 + 8 * i + kr]; } }
#pragma unroll
      for (int i = 0; i < 8; ++i) { const int kk = 8 * i + kr;
#pragma unroll
          for (int e = 0; e < 4; ++e) scr[kk * 33 + c4 + e] = v[i][e]; } }
    LDS_WAIT();
    const int c = lane & 7;
    bf16_t* WTb = WT + (size_t)(dst_row0 + n0) * K + k0;
#pragma unroll
    for (int j = 0; j < 4; ++j) { const int n = (lane >> 3) + 8 * j; const LAS float* s = scr + (8 * c) * 33 + n;
        u32x4 o; o.x = pk2(s[0 * 33], s[1 * 33]); o.y = pk2(s[2 * 33], s[3 * 33]); o.z = pk2(s[4 * 33], s[5 * 33]); o.w = pk2(s[6 * 33], s[7 * 33]);
        sto<u32x4>(WTb, ((unsigned)n * (unsigned)K + 8u * (unsigned)c) * 2u, o); }
    LDS_WAIT();
}
constexpr int ITEMS_PER_LAYER = 4608;
__device__ __forceinline__ void p0_weight_item(const Args& A, int l, int r, LAS float* scr, int lane) {
    unsigned char* wb = A.ws + WS_WB;
    const float* w_in = A.in[7] + (size_t)l * 1024 * DIN; const float* ng = A.in[6] + l * 1024;
    bf16_t* W1 = (bf16_t*)(wb + WB_W1); bf16_t* W2 = (bf16_t*)(wb + WB_W2);
    if (r < 768) { transpose_item(w_in, DIN, 2176, W1, 1024, 0, ng, scr, r / 48, r % 48, lane); return; } r -= 768;
    if (r < 512) { transpose_item(w_in, DIN, 4736, W1, 1024, 1536, ng, scr, r / 32, r % 32, lane); return; } r -= 512;
    if (r < 832) { transpose_item(w_in, DIN, 0, W2, 1024, 0, ng, scr, r / 52, r % 52, lane); return; } r -= 832;
    if (r < 16) { transpose_item(l > 0 ? A.in[13] + (size_t)(l - 1) * 1024 * 32 : nullptr, 32, 0, W2, 1024, 1664, ng, scr, r, 0, lane); return; } r -= 16;
    if (r < 48) { transpose_item(nullptr, 0, 0, W2, 1024, 1696, nullptr, scr, r / 3, r % 3, lane); return; } r -= 48;
    if (r < 256) { transpose_item(w_in, DIN, 1664, W1, 1024, 2560, ng, scr, r / 16, r % 16, lane); return; } r -= 256;
    if (r < 512) { transpose_item(w_in, DIN, 3712, W2, 1024, 1792, ng, scr, r / 32, r % 32, lane); return; } r -= 512;
    if (r < 256) { transpose_item(A.in[25] + (size_t)l * 512 * 1024, 1024, 0, (bf16_t*)(wb + WB_BA), 512, 0, nullptr, scr, r / 32, r % 32, lane); return; } r -= 256;
    if (r < 256) { transpose_item(A.in[26] + (size_t)l * 512 * 1024, 1024, 0, (bf16_t*)(wb + WB_BB), 512, 0, nullptr, scr, r / 32, r % 32, lane); return; } r -= 256;
    if (r < 512) { transpose_item(A.in[27] + (size_t)l * 1024 * 1024, 1024, 0, (bf16_t*)(wb + WB_OUT), 1024, 0, nullptr, scr, r / 32, r % 32, lane); return; } r -= 512;
    if (r < 128) { transpose_item(A.in[28] + (size_t)l * 256 * 1024, 1024, 0, (bf16_t*)(wb + WB_PLE), 256, 0, nullptr, scr, r / 32, r % 32, lane); return; } r -= 128;
    transpose_item(A.in[29] + (size_t)l * 1024 * 1024, 1024, 0, (bf16_t*)(wb + ((l & 1) ? WB_GATE_ALT : WB_GATE)), 1024, 0, nullptr, scr, r / 32, r % 32, lane);
}
__device__ __forceinline__ void p0_prologue(CArgs Ap, int wv, LAS unsigned char* lds, int G) {
    const Args A = load_args(Ap);
    const int tid = opaque_tid(wv), lane = tid & 63, wave = wv;
    LAS float* scr = (LAS float*)(lds + wave * 16384);
    const int gw = blockIdx.x * 8 + wave, NGW = G * 8;
    for (int j = gw; j < 1536; j += NGW) p0_weight_item(A, 0, j < 1280 ? j : j + 896, scr, lane);
    bf16_t* XB = (bf16_t*)(A.ws + WS_XB); float* SSQ = (float*)(A.ws + WS_SSQ);
    constexpr int XR = 4;
    for (int m0 = gw; m0 < MT; m0 += XR * NGW) {
        f32x4 v[XR][4];
#pragma unroll
        for (int b = 0; b < XR; ++b) { const int m = m0 + b * NGW;
            if (m < MR) { const f32x4* xr = (const f32x4*)(m < MP ? A.in[0] + (size_t)m * 1024 : A.in[1] + (size_t)(m - MP) * 1024) + lane;
#pragma unroll
                for (int j = 0; j < 4; ++j) v[b][j] = __builtin_nontemporal_load(&xr[64 * j]); }
            else {
#pragma unroll
                for (int j = 0; j < 4; ++j) v[b][j] = (f32x4){0.f, 0.f, 0.f, 0.f}; } }
#pragma unroll
        for (int b = 0; b < XR; ++b) { const int m = m0 + b * NGW;
            if (m < MT) { float s = 0.f;
#pragma unroll
                for (int j = 0; j < 4; ++j) s += dot4(v[b][j], v[b][j]);
                s = wave_sum(s);
                u32x2* o8 = (u32x2*)(XB + (size_t)m * 1024) + lane;
#pragma unroll
                for (int j = 0; j < 4; ++j) { u32x2 w; w.x = pk2(v[b][j].x, v[b][j].y); w.y = pk2(v[b][j].z, v[b][j].w); o8[64 * j] = w; }
                if (lane < 16) SSQ[(size_t)m * 16 + lane] = lane == 0 ? s : 0.f;
                if (m >= MP && m < MR) SSQ[(size_t)MT * 16 + (size_t)(m - MP) * 64 + lane] = lane == 0 ? s : 0.f; } }
    }
}
__device__ __forceinline__ void pb_convert(const Args& A, int l, int gw, int NGW, int lane) {
    bf16_t* PB = (bf16_t*)(A.ws + WS_PB);
    constexpr int PR = 5;
    for (int m0 = gw; m0 < MT; m0 += PR * NGW) { f32x4 p[PR];
#pragma unroll
        for (int b = 0; b < PR; ++b) { const int m = m0 + b * NGW; p[b] = (f32x4){0.f, 0.f, 0.f, 0.f};
            if (m < MR) p[b] = __builtin_nontemporal_load((const f32x4*)(m < MP ? A.in[4] + ((size_t)l * MP + m) * 256 : A.in[5] + ((size_t)l * NS + (m - MP)) * 256) + lane); }
#pragma unroll
        for (int b = 0; b < PR; ++b) { const int m = m0 + b * NGW;
            if (m < MT) { u32x2 w; w.x = pk2(p[b].x, p[b].y); w.y = pk2(p[b].z, p[b].w); *((u32x2*)(PB + (size_t)m * 256) + lane) = w; } } }
}
__device__ __forceinline__ void convert_layer(const Args& A, int l, int wv, LAS unsigned char* lds, int G) {
    const int tid = opaque_tid(wv), lane = tid & 63, wave = wv;
    LAS float* scr = (LAS float*)(lds + wave * 16384);
    const int gw = blockIdx.x * 8 + wave, NGW = G * 8;
    for (int it = gw; it < ITEMS_PER_LAYER; it += NGW) p0_weight_item(A, l, it, scr, lane);
    pb_convert(A, l, gw, NGW, lane);
}

typedef float f32x16 __attribute__((ext_vector_type(16)));
constexpr int VNP = 136;
constexpr int MIX_WM = 0, MIX_ST = 34816, MIX_SV = 36864, MIX_VNT = MIX_SV + 34816, MIX_SM = MIX_SV, SMP = 132;
__device__ __forceinline__ void mix_phase(CArgs Ap, int wv, int l, LAS unsigned char* lds, int G, int dry = 0) {
    const Args A = load_args(Ap);
    const int tid = opaque_tid(wv), lane = tid & 63, wave = __builtin_amdgcn_readfirstlane(tid >> 6);
    bf16_t* U = (bf16_t*)(A.ws + G_U); const bf16_t* VB = (const bf16_t*)(A.ws + G_VB); const bf16_t* GB = (const bf16_t*)(A.ws + G_GB); bf16_t* UO = dry ? (bf16_t*)(A.ws + WS_BRB) : U;
    const float* lng = A.in[21] + l * 512; const float* lnb = A.in[22] + l * 512;
    const float* Wsp = A.in[23] + (size_t)l * 4 * 128 * 128; const float* bsp = A.in[24] + (size_t)l * 4 * 128;
    float* cv = A.out + O_CV + (size_t)l * NS * 512; const float* LNS = (const float*)(A.ws + WS_LNS);
    LAS bf16_t* WM = (LAS bf16_t*)(lds + MIX_WM); LAS bf16_t* VNt = (LAS bf16_t*)(lds + MIX_VNT); LAS unsigned char* SV = lds + MIX_SV; LAS float* SM = (LAS float*)(lds + MIX_SM);
    LAS float* ST = (LAS float*)(lds + MIX_ST);
    const int tid_phase = tid;
    int gcur = -1;
    if (wave == 0) for (int p = blockIdx.x; p < 2 * NS; p += G) {
        const int tt = p >> 1, hb = p & 1; const unsigned off = ((unsigned)(MP + tt) * 512u + 8u * (unsigned)lane) * 2u;
        f32x4 a, b, u0, u1, q0, q1; { const u32x4 tv = ldo<u32x4>(VB, off), tu = ldo<u32x4>(U, off), tg = ldo<u32x4>(GB, off); unpack8(tv, a, b); unpack8(tu, u0, u1); unpack8(tg, q0, q1); }
        const unsigned ch = 8u * (unsigned)lane; const int g = lane >> 4;
        const f32x4 lg0 = ldo<f32x4>(lng, ch * 4), lg1 = ldo<f32x4>(lng + 4, ch * 4), lb0 = ldo<f32x4>(lnb, ch * 4), lb1 = ldo<f32x4>(lnb + 4, ch * 4);
        const float w00 = Wsp[(size_t)g * 128 * 128], b00 = bsp[g * 128];
        const float mean = wave_sum(((a[0] + a[1]) + (a[2] + a[3])) + ((b[0] + b[1]) + (b[2] + b[3]))) * (1.0f / 512.0f);
        a = a - mean; b = b - mean;
        const float rstd = __builtin_amdgcn_rsqf(wave_sum(dot4(a, a) + dot4(b, b)) * (1.0f / 512.0f) + 1e-5f);
        a = a * rstd * lg0 + lb0; b = b * rstd * lg1 + lb1;
        if ((lane >> 5) == hb) {
            sto<f32x4>(cv + (size_t)tt * 512, ch * 4, a); sto<f32x4>(cv + (size_t)tt * 512 + 4, ch * 4, b);
            sto<u32x4>(UO, off, pack8(u0 * (a * w00 + b00) * q0, u1 * (b * w00 + b00) * q1)); }
    }
    for (int unit = blockIdx.x; unit < 128 * 4; unit += G) {
        int tid = tid_phase; asm volatile("" : "+v"(tid));
        const int lane = tid & 63;
        const int cidx = unit >> 2, g = unit & 3, m0 = cidx * 128;
        const int tt4 = wave >> 1, chf = wave & 1, tl = lane & 31, hh = lane >> 5, t = 32 * tt4 + tl;
        u32x4 vbr[4], ur[4], gr[4];
        const unsigned rmo = (unsigned)(((m0 + (tid >> 4)) * 512 + g * 128 + 8 * (tid & 15)) * 2);
#pragma unroll
        for (int k = 0; k < 4; ++k) vbr[k] = ldo<u32x4>(VB + (size_t)k * 32 * 512, rmo);
#pragma unroll
        for (int k = 0; k < 4; ++k) { ur[k] = ldo<u32x4>(U + (size_t)k * 32 * 512, rmo); gr[k] = ldo<u32x4>(GB + (size_t)k * 32 * 512, rmo); }
        f32x4 lg[2][2], lb[2][2];
#pragma unroll
        for (int hf = 0; hf < 2; ++hf) { const int cc = 8 * (2 * wave + hf); lg[hf][0] = *(const f32x4*)(lng + g * 128 + cc); lg[hf][1] = *(const f32x4*)(lng + g * 128 + cc + 4); lb[hf][0] = *(const f32x4*)(lnb + g * 128 + cc); lb[hf][1] = *(const f32x4*)(lnb + g * 128 + cc + 4); }
        const float bt = bsp[g * 128 + t];
        if (lane < 16) { const int tt = wave * 16 + lane; const f32x4* lp = (const f32x4*)(LNS + (size_t)(m0 + tt) * 16);
            const f32x4 p0 = lp[0], p1 = lp[1], p2 = lp[2], p3 = lp[3];
            const float s1 = ((p0.x + p0.z) + (p1.x + p1.z)) + ((p2.x + p2.z) + (p3.x + p3.z)), s2 = ((p0.y + p0.w) + (p1.y + p1.w)) + ((p2.y + p2.w) + (p3.y + p3.w));
            const float mean = s1 * (1.0f / 512.0f), var = fmaxf(s2 * (1.0f / 512.0f) - mean * mean, 0.f);
            ST[tt * 2] = mean; ST[tt * 2 + 1] = __builtin_amdgcn_rsqf(var + 1e-5f); }
        if (g != gcur) {
            gcur = g;
#pragma unroll
            for (int k = 0; k < 8; ++k) { const int i = tid + 512 * k, tr = i >> 5, s4 = (i & 31) * 4;
                f32x4 w = ldo<f32x4>(Wsp + (size_t)g * 128 * 128, (unsigned)i * 16u);
#pragma unroll
                for (int j = 0; j < 4; ++j) w[j] = s4 + j <= tr ? w[j] : 0.f;
                u32x2 o; o.x = pk2(w[0], w[1]); o.y = pk2(w[2], w[3]); *(LAS u32x2*)(WM + tr * VNP + s4) = o; } }
#pragma unroll
        for (int k = 0; k < 4; ++k) *(LAS u32x4*)(SV + ((tid >> 4) + 32 * k) * 272 + (tid & 15) * 16) = vbr[k];
        __syncthreads();
        { const float m0_ = ST[4 * lane], r0_ = ST[4 * lane + 1], m1_ = ST[4 * lane + 2], r1_ = ST[4 * lane + 3];
          LAS unsigned* VN32 = (LAS unsigned*)VNt;
#pragma unroll
          for (int hf = 0; hf < 2; ++hf) { const int cc = 8 * (2 * wave + hf);
              const f32x4 g0 = lg[hf][0], g1 = lg[hf][1], b0 = lb[hf][0], b1 = lb[hf][1];
              f32x4 a0, a1, c0, c1; { const u32x4 ta = *(const LAS u32x4*)(SV + (2 * lane) * 272 + cc * 2), tc = *(const LAS u32x4*)(SV + (2 * lane + 1) * 272 + cc * 2); unpack8(ta, a0, a1); unpack8(tc, c0, c1); }
              a0 = (a0 - m0_) * r0_ * g0 + b0; a1 = (a1 - m0_) * r0_ * g1 + b1; c0 = (c0 - m1_) * r1_ * g0 + b0; c1 = (c1 - m1_) * r1_ * g1 + b1;
#pragma unroll
              for (int e = 0; e < 4; ++e) { VN32[(cc + e) * (VNP / 2) + lane] = pk2(a0[e], c0[e]); VN32[(cc + 4 + e) * (VNP / 2) + lane] = pk2(a1[e], c1[e]); } } }
        __syncthreads();
        f32x16 acc[2];
#pragma unroll
        for (int i = 0; i < 16; ++i) { acc[0][i] = 0.f; acc[1][i] = 0.f; }
        const int nks = 2 * tt4 + 2;
#pragma unroll
        for (int ks = 0; ks < 8; ++ks) if (ks < nks) { const int s0 = 16 * ks + 8 * hh;
            const bf16x8 bf = *(const LAS bf16x8*)(WM + t * VNP + s0);
#pragma unroll
            for (int mi = 0; mi < 2; ++mi) { const bf16x8 af = *(const LAS bf16x8*)(VNt + (64 * chf + 32 * mi + tl) * VNP + s0);
                acc[mi] = __builtin_amdgcn_mfma_f32_32x32x16_bf16(af, bf, acc[mi], 0, 0, 0); } }
        __syncthreads();
        {
#pragma unroll
          for (int mi = 0; mi < 2; ++mi)
#pragma unroll
              for (int rg = 0; rg < 4; ++rg) { const f32x4 v = (f32x4){acc[mi][4 * rg] + bt, acc[mi][4 * rg + 1] + bt, acc[mi][4 * rg + 2] + bt, acc[mi][4 * rg + 3] + bt};
                  *(LAS f32x4*)(SM + t * SMP + 64 * chf + 32 * mi + 8 * rg + 4 * hh) = v; } }
        __syncthreads();
#pragma unroll
        for (int k = 0; k < 4; ++k) { const int r = (tid >> 4) + 32 * k, c8 = (tid & 15) * 8;
            const f32x4 ma = *(const LAS f32x4*)(SM + r * SMP + c8), mb = *(const LAS f32x4*)(SM + r * SMP + c8 + 4);
            f32x4 u0, u1, q0, q1; unpack8(ur[k], u0, u1); unpack8(gr[k], q0, q1);
            wt16(UO + (size_t)k * 32 * 512, rmo, pack8(u0 * ma * q0, u1 * mb * q1)); }
        __syncthreads();
    }
}

constexpr int REC = 336, RECS = 384, TC = 32, NCH = SEQ / TC, BUF_FLOATS = TC * REC;
struct ScanT {
    const bf16_t *R, *K, *V, *LORA; const bf16_t* VFIRST; bf16_t* VF; bf16_t* Y; float* RKP;
    const float *mu, *w0, *wup, *a0, *aup, *vup, *vb, *kk, *ka, *rk;
    const float* sh0;
};
__device__ __forceinline__ void reduce2(float& a, float& b) {
    a += dppmov<0xB1>(a); b += dppmov<0xB1>(b); a += dppmov<0x4E>(a); b += dppmov<0x4E>(b);
    a += dppmov<0x141>(a); b += dppmov<0x141>(b); a += dppmov<0x140>(a); b += dppmov<0x140>(b);
}
struct StepIn { f32x2 w0, w1, k0, k1, a0, a1, b0, b1, r0, r1; float v; };
#define LO2(t) __builtin_shufflevector(t, t, 0, 1)
#define HI2(t) __builtin_shufflevector(t, t, 2, 3)
__device__ __forceinline__ StepIn ld_step(const LAS float* rec, int cl, int vi) {
    StepIn s; const f32x4 w = *(const LAS f32x4*)(rec + 4 * cl), k = *(const LAS f32x4*)(rec + 64 + 4 * cl), a = *(const LAS f32x4*)(rec + 128 + 4 * cl),
                          b = *(const LAS f32x4*)(rec + 192 + 4 * cl), r = *(const LAS f32x4*)(rec + 256 + 4 * cl);
    s.w0 = LO2(w); s.w1 = HI2(w); s.k0 = LO2(k); s.k1 = HI2(k); s.a0 = LO2(a); s.a1 = HI2(a); s.b0 = LO2(b); s.b1 = HI2(b); s.r0 = LO2(r); s.r1 = HI2(r);
    s.v = rec[320 + vi]; return s;
}
__device__ __forceinline__ float scan_step2(f32x2& s0, f32x2& s1, float& ypart, const StepIn& in) {
    f32x2 t = s0 * in.a0; t = s1 * in.a1 + t;
    float p = t.x + t.y, yprev = ypart;
    reduce2(p, yprev);
    const f32x2 pv = (f32x2){p, p}, vv = (f32x2){in.v, in.v};
    s0 = s0 * in.w0 + (pv * in.b0 + vv * in.k0);
    s1 = s1 * in.w1 + (pv * in.b1 + vv * in.k1);
    f32x2 q = s0 * in.r0; q = s1 * in.r1 + q;
    ypart = q.x + q.y;
    return yprev;
}

struct LoraSet { u32x4 wd[2], ad[2], vd, pwd[2], pad_[2]; };
struct ElemSet { u32x2 r[2], k[2], v[2], k2[2], vf[2], pr[2], pk[2], pv[2], pk2[2]; };
struct PrepOff { unsigned m, m2, l; };
__device__ __forceinline__ PrepOff prep_off(unsigned m, int h, int nh, int kg) {
    PrepOff o; o.m = (m * 512u + (unsigned)(h * 64 + 32 * nh + 4 * kg)) * 2u; o.m2 = (m * 512u + (unsigned)(h * 64 + 32 * (1 - nh) + 4 * kg)) * 2u; o.l = (m * 256u + (unsigned)(8 * kg)) * 2u; return o;
}
template <bool SAMPLE> __device__ __forceinline__ void load_lora(const ScanT& T, const PrepOff o, bool hasprev, LoraSet& L) {
#pragma unroll
    for (int ks = 0; ks < 2; ++ks) { L.wd[ks] = ldo<u32x4>(T.LORA, o.l + 64 * ks); L.ad[ks] = ldo<u32x4>(T.LORA, o.l + 128 + 64 * ks); }
    L.vd = ldo<u32x4>(T.LORA, o.l + 256);
    if (!SAMPLE) { const u32x4 z4 = (u32x4){0u, 0u, 0u, 0u};
#pragma unroll
        for (int ks = 0; ks < 2; ++ks) { L.pwd[ks] = z4; L.pad_[ks] = z4; }
        if (hasprev) {
#pragma unroll
            for (int ks = 0; ks < 2; ++ks) { L.pwd[ks] = ldo<u32x4>(T.LORA, o.l + 64 * ks - 512); L.pad_[ks] = ldo<u32x4>(T.LORA, o.l + 128 + 64 * ks - 512); } } }
}
template <bool SAMPLE> __device__ __forceinline__ void load_elem(const ScanT& T, const PrepOff o, bool hasprev, ElemSet& E) {
#pragma unroll
    for (int nt = 0; nt < 2; ++nt) {
        E.r[nt] = ldo<u32x2>(T.R, o.m + 32 * nt); E.k[nt] = ldo<u32x2>(T.K, o.m + 32 * nt); E.v[nt] = ldo<u32x2>(T.V, o.m + 32 * nt); E.k2[nt] = ldo<u32x2>(T.K, o.m2 + 32 * nt);
        if (T.VFIRST) E.vf[nt] = ldo<u32x2>(T.VFIRST, o.m + 32 * nt); else E.vf[nt] = (u32x2){0u, 0u}; }
    if (!SAMPLE) { const u32x2 z2 = (u32x2){0u, 0u};
#pragma unroll
        for (int nt = 0; nt < 2; ++nt) { E.pr[nt] = z2; E.pk[nt] = z2; E.pv[nt] = z2; E.pk2[nt] = z2; }
        if (hasprev) {
#pragma unroll
            for (int nt = 0; nt < 2; ++nt) { E.pr[nt] = ldo<u32x2>(T.R, o.m + 32 * nt - 1024); E.pk[nt] = ldo<u32x2>(T.K, o.m + 32 * nt - 1024); E.pv[nt] = ldo<u32x2>(T.V, o.m + 32 * nt - 1024); E.pk2[nt] = ldo<u32x2>(T.K, o.m2 + 32 * nt - 1024); } } }
}
constexpr int PAR_MUR = 0, PAR_MUK = 64, PAR_MUV = 128, PAR_W0 = 192, PAR_A0 = 256, PAR_KK = 320, PAR_KA = 384, PAR_RK = 448, PAR_VB = 512, PAR_MUWD = 576, PAR_MUAD = 640, PAR_FLOATS = 704;
__device__ __forceinline__ void par_fill(const ScanT& T, int h, LAS float* PAR, int tid) {
    for (int i = tid; i < PAR_FLOATS; i += 512) { const int f = i >> 6, c = i & 63; float v = 0.f;
        if (f == 0) v = T.mu[h * 64 + c]; else if (f == 1) v = T.mu[512 + h * 64 + c]; else if (f == 2) v = T.mu[1024 + h * 64 + c];
        else if (f == 3) v = T.w0[h * 64 + c]; else if (f == 4) v = T.a0[h * 64 + c]; else if (f == 5) v = T.kk[h * 64 + c]; else if (f == 6) v = T.ka[h * 64 + c];
        else if (f == 7) v = T.rk[h * 64 + c]; else if (f == 8) v = T.vb ? T.vb[h * 64 + c] : 0.f; else if (f == 9) v = T.mu[1536 + c]; else v = T.mu[1600 + c];
        PAR[i] = v; }
}
template <bool SAMPLE>
__device__ __forceinline__ void lora_compute(const ScanT& T, const LAS float* PAR, const LoraSet& L, unsigned shj, int kg,
                                             const bf16x8 (&wupf)[2][2], const bf16x8 (&aupf)[2][2], const bf16x8 (&vuf)[2], f32x4 (&xw)[2], f32x4 (&xa)[2], f32x4 (&xv)[2]) {
    bf16x8 Tf[2], ADf[2];
    const unsigned pl = (unsigned)(8 * kg) * 4u;
#pragma unroll
    for (int ks = 0; ks < 2; ++ks) {
        f32x4 c0, c1, p0, p1; unpack8(L.wd[ks], c0, c1);
        if (SAMPLE) { p0 = ldo<f32x4>(T.sh0 + 1536, shj + pl + 128 * ks); p1 = ldo<f32x4>(T.sh0 + 1536, shj + pl + 128 * ks + 16); } else unpack8(L.pwd[ks], p0, p1);
        c0 = c0 + (p0 - c0) * *(const LAS f32x4*)(PAR + PAR_MUWD + 32 * ks + 8 * kg); c1 = c1 + (p1 - c1) * *(const LAS f32x4*)(PAR + PAR_MUWD + 32 * ks + 8 * kg + 4);
#pragma unroll
        for (int j = 0; j < 4; ++j) { c0[j] = tanhf_(c0[j]); c1[j] = tanhf_(c1[j]); }
        Tf[ks] = pack_bf8(c0, c1);
        unpack8(L.ad[ks], c0, c1);
        if (SAMPLE) { p0 = ldo<f32x4>(T.sh0 + 1600, shj + pl + 128 * ks); p1 = ldo<f32x4>(T.sh0 + 1600, shj + pl + 128 * ks + 16); } else unpack8(L.pad_[ks], p0, p1);
        c0 = c0 + (p0 - c0) * *(const LAS f32x4*)(PAR + PAR_MUAD + 32 * ks + 8 * kg); c1 = c1 + (p1 - c1) * *(const LAS f32x4*)(PAR + PAR_MUAD + 32 * ks + 8 * kg + 4);
        ADf[ks] = pack_bf8(c0, c1); }
    const bf16x8 VDf = __builtin_bit_cast(bf16x8, L.vd);
#pragma unroll
    for (int nt = 0; nt < 2; ++nt) { const f32x4 z = (f32x4){0.f, 0.f, 0.f, 0.f};
        xw[nt] = __builtin_amdgcn_mfma_f32_16x16x32_bf16(wupf[nt][0], Tf[0], z, 0, 0, 0); xw[nt] = __builtin_amdgcn_mfma_f32_16x16x32_bf16(wupf[nt][1], Tf[1], xw[nt], 0, 0, 0);
        xa[nt] = __builtin_amdgcn_mfma_f32_16x16x32_bf16(aupf[nt][0], ADf[0], z, 0, 0, 0); xa[nt] = __builtin_amdgcn_mfma_f32_16x16x32_bf16(aupf[nt][1], ADf[1], xa[nt], 0, 0, 0);
        xv[nt] = __builtin_amdgcn_mfma_f32_16x16x32_bf16(vuf[nt], VDf, z, 0, 0, 0); }
}
template <bool SAMPLE>
__device__ __forceinline__ void elem_compute(const ScanT& T, const LAS float* PAR, const ElemSet& E, const f32x4 (&xw)[2], const f32x4 (&xa)[2], const f32x4 (&xv)[2], const PrepOff o, unsigned m, unsigned shj,
                                             int h, int nh, int kg, bool wq, int v16base, LAS float* rec, bool recvalid) {
    f32x4 av[2], kkr[2]; float ssq = 0.f, rkp = 0.f;
    const unsigned pc = (unsigned)(h * 64 + 32 * nh + 4 * kg) * 4u, pc2 = (unsigned)(h * 64 + 32 * (1 - nh) + 4 * kg) * 4u;
#pragma unroll
    for (int nt = 0; nt < 2; ++nt) { const int chl = 32 * nh + 16 * nt + 4 * kg, chl2 = 32 * (1 - nh) + 16 * nt + 4 * kg;
        const f32x4 r0 = up4(E.r[nt]), k0 = up4(E.k[nt]), v0 = up4(E.v[nt]), k2 = up4(E.k2[nt]);
        f32x4 rp, kpv, vp, k2p;
        if (SAMPLE) { rp = ldo<f32x4>(T.sh0, shj + pc + 64 * nt); kpv = ldo<f32x4>(T.sh0 + 512, shj + pc + 64 * nt); vp = ldo<f32x4>(T.sh0 + 1024, shj + pc + 64 * nt); k2p = ldo<f32x4>(T.sh0 + 512, shj + pc2 + 64 * nt); }
        else { rp = up4(E.pr[nt]); kpv = up4(E.pk[nt]); vp = up4(E.pv[nt]); k2p = up4(E.pk2[nt]); }
        const f32x4 zsr = r0 + (rp - r0) * *(const LAS f32x4*)(PAR + PAR_MUR + chl), zsk = k0 + (kpv - k0) * *(const LAS f32x4*)(PAR + PAR_MUK + chl), zsv = v0 + (vp - v0) * *(const LAS f32x4*)(PAR + PAR_MUV + chl);
        const f32x4 w0v = *(const LAS f32x4*)(PAR + PAR_W0 + chl), a0v = *(const LAS f32x4*)(PAR + PAR_A0 + chl), kkv = *(const LAS f32x4*)(PAR + PAR_KK + chl), kav = *(const LAS f32x4*)(PAR + PAR_KA + chl), rkv = *(const LAS f32x4*)(PAR + PAR_RK + chl);
        f32x4 vfin = zsv;
        if (T.vup) { const f32x4 vbv = *(const LAS f32x4*)(PAR + PAR_VB + chl), vf = up4(E.vf[nt]);
#pragma unroll
            for (int e = 0; e < 4; ++e) vfin[e] = zsv[e] + (vf[e] - zsv[e]) * sigmoidf_(vbv[e] + xv[nt][e]); }
        if (wq) { u32x2 w; w.x = pk2(vfin[0], vfin[1]); w.y = pk2(vfin[2], vfin[3]); sto<u32x2>(T.VF, o.m + 32 * nt, w); }
        f32x4 dec, kp;
#pragma unroll
        for (int e = 0; e < 4; ++e) {
            const float sg = sigmoidf_(w0v[e] + xw[nt][e]); dec[e] = fexp(-0.60653065971f * sg);
            const float a = sigmoidf_(a0v[e] + xa[nt][e]); av[nt][e] = a;
            const float kr = zsk[e] * kkv[e]; kkr[nt][e] = kr; ssq += kr * kr;
            const float kq = zsk[e] * (1.0f + (a - 1.0f) * kav[e]); kp[e] = kq;
            rkp += zsr[e] * kq * rkv[e]; }
        const f32x4 zk2 = (k2 + (k2p - k2) * *(const LAS f32x4*)(PAR + PAR_MUK + chl2)) * *(const LAS f32x4*)(PAR + PAR_KK + chl2);
        ssq += dot4(zk2, zk2);
        if (recvalid) {
            *(LAS f32x4*)(rec + chl) = dec; *(LAS f32x4*)(rec + 64 + chl) = kp; *(LAS f32x4*)(rec + 256 + chl) = zsr;
            if (SAMPLE) *(LAS f32x4*)(rec + 320 + chl) = vfin;
            else if (32 * nh + 16 * nt == v16base) *(LAS f32x4*)(rec + 320 + 4 * kg) = vfin; }
    }
    ssq = xrow_sum(ssq); rkp = xrow_sum(rkp);
    const float nrm = 1.0f / fmaxf(__builtin_sqrtf(ssq), 1e-12f);
    if (wq && kg == 0) sto<float>(T.RKP, (m * 16u + (unsigned)(2 * h + nh)) * 4u, rkp);
    if (recvalid) {
#pragma unroll
        for (int nt = 0; nt < 2; ++nt) { const int chl = 32 * nh + 16 * nt + 4 * kg;
            const f32x4 kkn = kkr[nt] * nrm;
            *(LAS f32x4*)(rec + 128 + chl) = -kkn; *(LAS f32x4*)(rec + 192 + chl) = kkn * av[nt]; }
    }
}
__device__ __forceinline__ void prep_frags(const ScanT& T, int h, int nh, int lane, bf16x8 (&wupf)[2][2], bf16x8 (&aupf)[2][2], bf16x8 (&vuf)[2]) {
    const int rr = lane & 15, kg = lane >> 4;
    const unsigned voff = ((unsigned)(8 * kg) * 512u + (unsigned)(h * 64 + 32 * nh + rr)) * 4u;
#pragma unroll
    for (int nt = 0; nt < 2; ++nt) {
#pragma unroll
        for (int ks = 0; ks < 2; ++ks)
#pragma unroll
            for (int j = 0; j < 8; ++j) { const int uo = (32 * ks + j) * 512 + 16 * nt; wupf[nt][ks][j] = (short)f2bf(ldo<float>(T.wup + uo, voff)); aupf[nt][ks][j] = (short)f2bf(ldo<float>(T.aup + uo, voff)); }
        if (T.vup) {
#pragma unroll
            for (int j = 0; j < 8; ++j) vuf[nt][j] = (short)f2bf(ldo<float>(T.vup + j * 512 + 16 * nt, voff)); }
        else {
#pragma unroll
            for (int j = 0; j < 8; ++j) vuf[nt][j] = (short)0; } }
}

__device__ __forceinline__ void scan_sample_group(const Args& A, const ScanT& T, int l, int ig, LAS unsigned char* lds, int wv, int dry = 0) {
    const int tid = opaque_tid(wv); ig = opaque_s(ig);
    const int lane = tid & 63, wave = __builtin_amdgcn_readfirstlane(tid >> 6);
    const int h = ig & 7, jg = ig >> 3;
    LAS float* PAR = (LAS float*)lds;
    LAS float* BUF = PAR + PAR_FLOATS + 64;
    par_fill(T, h, PAR, tid);
    __syncthreads();
    if (wave == 4 || wave == 5) {
        const int nh = wave - 4, tokl = lane & 15, kg = lane >> 4, j = 4 * jg + (tokl & 3);
        bf16x8 wupf[2][2], aupf[2][2], vuf[2];
        prep_frags(T, h, nh, lane, wupf, aupf, vuf);
        const unsigned m = (unsigned)MP + j; const PrepOff o = prep_off(m, h, nh, kg); const unsigned shj = (unsigned)j * (unsigned)NSHIFT * 4u;
        LoraSet L; ElemSet E; load_lora<true>(T, o, false, L); load_elem<true>(T, o, false, E);
        f32x4 xw[2], xa[2], xv[2];
        lora_compute<true>(T, PAR, L, shj, kg, wupf, aupf, vuf, xw, xa, xv);
        elem_compute<true>(T, PAR, E, xw, xa, xv, o, m, shj, h, nh, kg, tokl < 4 && !dry, 0, BUF + (tokl & 3) * RECS, tokl < 4);
    }
    __syncthreads();
    {
        const int ii = wave >> 1, half = wave & 1, j = 4 * jg + ii, rl = lane >> 4, cl = lane & 15; const size_t m = (size_t)MP + j;
        const LAS float* rec = BUF + ii * RECS;
        StepIn in = ld_step(rec, cl, 0);
        const float* S0 = A.in[2] + (((size_t)l * NS + j) * NH + h) * 4096; float* S1 = A.out + O_WKVS + (((size_t)l * NS + j) * NH + h) * 4096;
        f32x4 sv[8];
#pragma unroll
        for (int rg = 0; rg < 8; ++rg) sv[rg] = __builtin_nontemporal_load((const f32x4*)(S0 + (32 * half + 4 * rg + rl) * 64 + 4 * cl));
#pragma unroll
        for (int rg = 0; rg < 8; ++rg) { const int i = 32 * half + 4 * rg + rl; in.v = rec[320 + i];
            f32x2 a0 = LO2(sv[rg]), a1 = HI2(sv[rg]); float yp = 0.f; (void)scan_step2(a0, a1, yp, in); float d = 0.f; reduce2(yp, d);
            if (!dry) { wt16nt(S1, (unsigned)((i * 64 + 4 * cl) * 4), __builtin_bit_cast(u32x4, (f32x4){a0.x, a0.y, a1.x, a1.y}));
            if (cl == 0) T.Y[m * 512 + h * 64 + i] = (bf16_t)f2bf(yp); } else asm volatile("" :: "v"(a0), "v"(a1), "v"(yp)); }
    }
    __syncthreads();
}


#ifndef REP_SAMPLE_DRY
#define REP_SAMPLE_DRY 0
#endif
#ifndef REP_PREP_DRY
#define REP_PREP_DRY 0
#endif
#ifndef REP_CHUNK
#define REP_CHUNK 1
#endif
#ifndef REP_PLE
#define REP_PLE 1
#endif
#ifndef REP_CHUNK_DRY
#define REP_CHUNK_DRY 0
#endif
constexpr int PK_SMALL = 4608;
__device__ __forceinline__ unsigned pk_lane_rows(int lane) { return (unsigned)((lane >> 3) * 1024 + (lane & 7) * 16); }
__device__ __forceinline__ unsigned char* pk_a1(unsigned char* ws, int tile, int h, int f) { return ws + (f < 2 ? G_R : G_K) + (size_t)tile * 16384 + (size_t)(f & 1) * 8192 + (size_t)h * 128; }
__device__ __forceinline__ unsigned char* pk_a4lo(unsigned char* ws, int tile, int h, int jt) { return ws + G_V + (size_t)tile * 16384 + (size_t)jt * 8192 + (size_t)h * 128; }
__device__ __forceinline__ unsigned char* pk_a4hi(unsigned char* ob, int tile, int h, int jt) { return ob + OS_PKA4 + (((size_t)tile * 8 + h) * 2 + (jt - 2)) * 1024; }
__device__ __forceinline__ unsigned char* pk_small(unsigned char* ws, int tile, int h) { return ws + WS_PKS + ((size_t)tile * 8 + h) * PK_SMALL; }
template <int CTRL, bool BC> __device__ __forceinline__ float dppf(float x) { return __builtin_bit_cast(float, __builtin_amdgcn_update_dpp(0, __builtin_bit_cast(int, x), CTRL, 0xf, 0xf, BC)); }
template <int CTRL, bool BC> __device__ __forceinline__ unsigned dppu(unsigned x) { return (unsigned)__builtin_amdgcn_update_dpp(0, (int)x, CTRL, 0xf, 0xf, BC); }
__device__ __forceinline__ unsigned prev_dw(unsigned cur, unsigned carry, bool first) { const unsigned p = dppu<0x121, false>(cur); return first ? carry : p; }
__device__ __forceinline__ f32x4 prod16(const f32x4 XT, const f32x4 Y) {
    f32x4 z = (f32x4){0.f, 0.f, 0.f, 0.f};
#pragma unroll
    for (int q = 0; q < 4; ++q) z = __builtin_amdgcn_mfma_f32_16x16x4f32(XT[q], Y[q], z, 0, 0, 0);
    return z;
}
__device__ __forceinline__ float nopack(float x) { asm("" : "+v"(x)); return x; }
__device__ __forceinline__ bf16x8 asbf8(const u32x4 w) { return __builtin_bit_cast(bf16x8, w); }

__device__ __forceinline__ void prep_phase(CArgs Ap, int wv, int l, LAS unsigned char* lds, int G, int dry = 0) {
    const Args A = load_args(Ap);
    const int tid = opaque_tid(wv), lane = tid & 63, tok = lane & 15, kg = lane >> 4;
    const bf16_t* R = (const bf16_t*)(A.ws + G_R); const bf16_t* K = (const bf16_t*)(A.ws + G_K); const bf16_t* V = (const bf16_t*)(A.ws + G_V); const bf16_t* LORA = (const bf16_t*)(A.ws + G_LORA);
    bf16_t* V0 = (bf16_t*)(A.ws + WS_V0); float* RKP = (float*)(A.ws + WS_RKP); const bf16_t* HALO = (const bf16_t*)(A.ws + WS_HALO);
    ScanT T; T.mu = A.in[8] + (size_t)l * NSHIFT; T.w0 = A.in[9] + l * 512; T.wup = A.in[10] + (size_t)l * 64 * 512; T.a0 = A.in[11] + l * 512; T.aup = A.in[12] + (size_t)l * 64 * 512;
    T.vup = l > 0 ? A.in[14] + (size_t)(l - 1) * 32 * 512 : nullptr; T.vb = l > 0 ? A.in[15] + (size_t)(l - 1) * 512 : nullptr;
    T.kk = A.in[16] + l * 512; T.ka = A.in[17] + l * 512; T.rk = A.in[18] + l * 512;
    const bool lay1 = l > 0;
    LAS float* PAR = (LAS float*)lds;
    LAS u32x4* FRAGS = (LAS u32x4*)(lds + 3072);
    LAS bf16_t* TR = (LAS bf16_t*)(lds + 24576 + wv * 6144);
    LAS unsigned* CAR = (LAS unsigned*)(lds + 73728 + wv * 768);
    const unsigned cl = (unsigned)(lane & 15); const bool first = tok == 0;
    for (int u = blockIdx.x; u < 256; u += G) {
        const int h = u & 7, rb = 8 * (u >> 3) + wv;
        __syncthreads();
        par_fill(T, h, PAR, tid);
        for (int f = wv; f < 20; f += 8) { const int nt = f / 5, kind = f % 5; f32x4 a = (f32x4){0.f, 0.f, 0.f, 0.f}, b = a;
            const unsigned voff = ((unsigned)(8 * kg) * 512u + (unsigned)(h * 64 + 16 * nt + tok)) * 4u;
            const float* src = kind < 2 ? T.wup + 32 * kind * 512 : (kind < 4 ? T.aup + 32 * (kind - 2) * 512 : T.vup);
            if (src != nullptr) {
#pragma unroll
                for (int j = 0; j < 4; ++j) { a[j] = ldo<float>(src + j * 512, voff); b[j] = ldo<float>(src + (4 + j) * 512, voff); } }
            FRAGS[f * 64 + lane] = pack8(a, b); }
        __syncthreads();
        { const bool seqstart = (rb & 31) == 0; const unsigned hb = (unsigned)rb * 1792u;
          if (tok == 15) {
#pragma unroll
              for (int t3 = 0; t3 < 3; ++t3)
#pragma unroll
                  for (int nt = 0; nt < 4; ++nt) { u32x2 w = (u32x2){0u, 0u}; if (!seqstart) w = ldo<u32x2>(HALO, (hb + (unsigned)(t3 * 512 + h * 64 + 16 * nt + 4 * kg)) * 2u);
                      CAR[kg * 40 + (t3 * 4 + nt) * 2] = w.x; CAR[kg * 40 + (t3 * 4 + nt) * 2 + 1] = w.y; }
#pragma unroll
              for (int wa = 0; wa < 2; ++wa)
#pragma unroll
                  for (int ks = 0; ks < 2; ++ks) { u32x4 w = (u32x4){0u, 0u, 0u, 0u}; if (!seqstart) w = ldo<u32x4>(HALO, (hb + (unsigned)(1536 + 64 * wa + 32 * ks + 8 * kg)) * 2u);
#pragma unroll
                      for (int i = 0; i < 4; ++i) CAR[kg * 40 + 24 + (wa * 2 + ks) * 4 + i] = w[i]; } }
          LDS_WAIT(); }
#pragma unroll 1
        for (int c = 0; c < 4; ++c) {
            const int m0 = 64 * rb + 16 * c, tile = m0 >> 4; const unsigned m = (unsigned)(m0 + tok);
            const unsigned om = (m * 512u + (unsigned)(h * 64 + 4 * kg)) * 2u, ol = (m * 256u + (unsigned)(8 * kg)) * 2u;
            u32x4 wd[2], ad[2], vd; u32x2 rr[4], kr_[4], vr[4], vf[4];
#pragma unroll
            for (int ks = 0; ks < 2; ++ks) { wd[ks] = ldo<u32x4>(LORA, ol + 64 * ks); ad[ks] = ldo<u32x4>(LORA, ol + 128 + 64 * ks); }
            vd = ldo<u32x4>(LORA, ol + 256);
#pragma unroll
            for (int nt = 0; nt < 4; ++nt) { rr[nt] = ldo<u32x2>(R, om + 32 * nt); kr_[nt] = ldo<u32x2>(K, om + 32 * nt); vr[nt] = ldo<u32x2>(V, om + 32 * nt);
                vf[nt] = lay1 ? ldo<u32x2>(V0, om + 32 * nt) : (u32x2){0u, 0u}; }
            u32x4 pwd[2], pad_[2]; u32x2 pr[4], pk[4], pv[4];
#pragma unroll
            for (int nt = 0; nt < 4; ++nt) {
                pr[nt].x = prev_dw(rr[nt].x, CAR[kg * 40 + (0 + nt) * 2], first); pr[nt].y = prev_dw(rr[nt].y, CAR[kg * 40 + (0 + nt) * 2 + 1], first);
                pk[nt].x = prev_dw(kr_[nt].x, CAR[kg * 40 + (4 + nt) * 2], first); pk[nt].y = prev_dw(kr_[nt].y, CAR[kg * 40 + (4 + nt) * 2 + 1], first);
                pv[nt].x = prev_dw(vr[nt].x, CAR[kg * 40 + (8 + nt) * 2], first); pv[nt].y = prev_dw(vr[nt].y, CAR[kg * 40 + (8 + nt) * 2 + 1], first); }
#pragma unroll
            for (int ks = 0; ks < 2; ++ks)
#pragma unroll
                for (int i = 0; i < 4; ++i) { pwd[ks][i] = prev_dw(wd[ks][i], CAR[kg * 40 + 24 + ks * 4 + i], first); pad_[ks][i] = prev_dw(ad[ks][i], CAR[kg * 40 + 24 + (2 + ks) * 4 + i], first); }
            LDS_WAIT();
            if (tok == 15) {
#pragma unroll
                for (int nt = 0; nt < 4; ++nt) { CAR[kg * 40 + nt * 2] = rr[nt].x; CAR[kg * 40 + nt * 2 + 1] = rr[nt].y; CAR[kg * 40 + (4 + nt) * 2] = kr_[nt].x; CAR[kg * 40 + (4 + nt) * 2 + 1] = kr_[nt].y;
                    CAR[kg * 40 + (8 + nt) * 2] = vr[nt].x; CAR[kg * 40 + (8 + nt) * 2 + 1] = vr[nt].y; }
#pragma unroll
                for (int ks = 0; ks < 2; ++ks)
#pragma unroll
                    for (int i = 0; i < 4; ++i) { CAR[kg * 40 + 24 + ks * 4 + i] = wd[ks][i]; CAR[kg * 40 + 24 + (2 + ks) * 4 + i] = ad[ks][i]; } }
            f32x4 xw[4], xa[4], xv[4];
            { bf16x8 Tf[2], ADf[2];
#pragma unroll
              for (int ks = 0; ks < 2; ++ks) { f32x4 c0, c1, p0, p1; unpack8(wd[ks], c0, c1); unpack8(pwd[ks], p0, p1);
                  c0 = c0 + (p0 - c0) * *(const LAS f32x4*)(PAR + PAR_MUWD + 32 * ks + 8 * kg); c1 = c1 + (p1 - c1) * *(const LAS f32x4*)(PAR + PAR_MUWD + 32 * ks + 8 * kg + 4);
#pragma unroll
                  for (int j = 0; j < 4; ++j) { c0[j] = tanhf_(c0[j]); c1[j] = tanhf_(c1[j]); }
                  Tf[ks] = pack_bf8(c0, c1);
                  unpack8(ad[ks], c0, c1); unpack8(pad_[ks], p0, p1);
                  c0 = c0 + (p0 - c0) * *(const LAS f32x4*)(PAR + PAR_MUAD + 32 * ks + 8 * kg); c1 = c1 + (p1 - c1) * *(const LAS f32x4*)(PAR + PAR_MUAD + 32 * ks + 8 * kg + 4);
                  ADf[ks] = pack_bf8(c0, c1); }
              const bf16x8 VDf = asbf8(vd);
#pragma unroll
              for (int nt = 0; nt < 4; ++nt) { const f32x4 z = (f32x4){0.f, 0.f, 0.f, 0.f};
                  xw[nt] = __builtin_amdgcn_mfma_f32_16x16x32_bf16(asbf8(FRAGS[(nt * 5 + 0) * 64 + lane]), Tf[0], z, 0, 0, 0); xw[nt] = __builtin_amdgcn_mfma_f32_16x16x32_bf16(asbf8(FRAGS[(nt * 5 + 1) * 64 + lane]), Tf[1], xw[nt], 0, 0, 0);
                  xa[nt] = __builtin_amdgcn_mfma_f32_16x16x32_bf16(asbf8(FRAGS[(nt * 5 + 2) * 64 + lane]), ADf[0], z, 0, 0, 0); xa[nt] = __builtin_amdgcn_mfma_f32_16x16x32_bf16(asbf8(FRAGS[(nt * 5 + 3) * 64 + lane]), ADf[1], xa[nt], 0, 0, 0);
                  xv[nt] = __builtin_amdgcn_mfma_f32_16x16x32_bf16(asbf8(FRAGS[(nt * 5 + 4) * 64 + lane]), VDf, z, 0, 0, 0); } }
            f32x4 zsk[4]; float ssq = 0.f;
#pragma unroll
            for (int nt = 0; nt < 4; ++nt) { const f32x4 k0 = up4(kr_[nt]), kp0 = up4(pk[nt]); zsk[nt] = k0 + (kp0 - k0) * *(const LAS f32x4*)(PAR + PAR_MUK + 16 * nt + 4 * kg);
                const f32x4 krw = zsk[nt] * *(const LAS f32x4*)(PAR + PAR_KK + 16 * nt + 4 * kg); ssq += dot4(krw, krw); }
            ssq = xrow_sum(ssq);
            const float nrm = 1.0f / fmaxf(__builtin_sqrtf(ssq), 1e-12f);
            u32x4 afr[2], rfr[2], bfr[2], kfr[2]; float rkp = 0.f;
            unsigned char* sm = pk_small(A.ws, tile, h);
#pragma unroll
            for (int nt = 0; nt < 4; ++nt) { const int chl = 16 * nt + 4 * kg;
                const f32x4 r0 = up4(rr[nt]), rp = up4(pr[nt]), v0 = up4(vr[nt]), vp = up4(pv[nt]);
                const f32x4 zsr = r0 + (rp - r0) * *(const LAS f32x4*)(PAR + PAR_MUR + chl), zsv = v0 + (vp - v0) * *(const LAS f32x4*)(PAR + PAR_MUV + chl);
                const f32x4 w0v = *(const LAS f32x4*)(PAR + PAR_W0 + chl), a0v = *(const LAS f32x4*)(PAR + PAR_A0 + chl), kkv = *(const LAS f32x4*)(PAR + PAR_KK + chl), kav = *(const LAS f32x4*)(PAR + PAR_KA + chl), rkv = *(const LAS f32x4*)(PAR + PAR_RK + chl);
                f32x4 vfin = zsv;
                if (lay1) { const f32x4 vbv = *(const LAS f32x4*)(PAR + PAR_VB + chl), vfv = up4(vf[nt]);
#pragma unroll
                    for (int e = 0; e < 4; ++e) vfin[e] = zsv[e] + (vfv[e] - zsv[e]) * sigmoidf_(vbv[e] + xv[nt][e]); }
                if (!dry) { u32x2 w; w.x = pk2(vfin[0], vfin[1]); w.y = pk2(vfin[2], vfin[3]); sto<u32x2>(V0, om + 32 * nt, w); }
                f32x4 at, rt, bh, kh, bB, kB, g15;
#pragma unroll
                for (int e = 0; e < 4; ++e) {
                    const float lw = -0.60653065971f * sigmoidf_(w0v[e] + xw[nt][e]);
                    const float a = sigmoidf_(a0v[e] + xa[nt][e]);
                    const float kq = zsk[nt][e] * (1.0f + (a - 1.0f) * kav[e]);
                    rkp += zsr[e] * kq * rkv[e];
                    const float kkn = zsk[nt][e] * kkv[e] * nrm, bbv = kkn * a;
                    float P = lw; P += dppf<0x111, true>(P); P += dppf<0x112, true>(P); P += dppf<0x114, true>(P); P += dppf<0x118, true>(P);
                    const float P15 = dppf<0x15F, false>(P);
                    const float g = fexp(P), gm1 = fexp(P - lw), ig = fexp(-P), gr = fexp(P15 - P);
                    at[e] = -kkn * gm1; rt[e] = zsr[e] * g; bh[e] = bbv * ig; kh[e] = kq * ig; bB[e] = bbv * gr; kB[e] = kq * gr; g15[e] = g; }
                const int ks = nt >> 1, w2 = 2 * (nt & 1);
                afr[ks][w2] = pk2(at[0], at[1]); afr[ks][w2 + 1] = pk2(at[2], at[3]); rfr[ks][w2] = pk2(rt[0], rt[1]); rfr[ks][w2 + 1] = pk2(rt[2], rt[3]);
                bfr[ks][w2] = pk2(bh[0], bh[1]); bfr[ks][w2 + 1] = pk2(bh[2], bh[3]); kfr[ks][w2] = pk2(kh[0], kh[1]); kfr[ks][w2 + 1] = pk2(kh[2], kh[3]);
#pragma unroll
                for (int e = 0; e < 4; ++e) { TR[(chl + e) * 16 + tok] = (bf16_t)f2bf(bB[e]); TR[1024 + (chl + e) * 16 + tok] = (bf16_t)f2bf(kB[e]); TR[2048 + (chl + e) * 16 + tok] = (bf16_t)f2bf(vfin[e]); }
                if (tok == 15 && !dry) sto<f32x4>(sm, (unsigned)(4096 + chl * 4), g15);
            }
            rkp = xrow_sum(rkp);
            if (kg == 0 && !dry) { sto<float>(RKP, (m * 16u + (unsigned)(2 * h)) * 4u, rkp); sto<float>(RKP, (m * 16u + (unsigned)(2 * h + 1)) * 4u, 0.f); }
            const f32x4 z4 = (f32x4){0.f, 0.f, 0.f, 0.f};
            f32x4 Nab = __builtin_amdgcn_mfma_f32_16x16x32_bf16(asbf8(bfr[0]), asbf8(afr[0]), z4, 0, 0, 0); Nab = __builtin_amdgcn_mfma_f32_16x16x32_bf16(asbf8(bfr[1]), asbf8(afr[1]), Nab, 0, 0, 0);
            f32x4 NabT = __builtin_amdgcn_mfma_f32_16x16x32_bf16(asbf8(afr[0]), asbf8(bfr[0]), z4, 0, 0, 0); NabT = __builtin_amdgcn_mfma_f32_16x16x32_bf16(asbf8(afr[1]), asbf8(bfr[1]), NabT, 0, 0, 0);
            f32x4 NakT = __builtin_amdgcn_mfma_f32_16x16x32_bf16(asbf8(afr[0]), asbf8(kfr[0]), z4, 0, 0, 0); NakT = __builtin_amdgcn_mfma_f32_16x16x32_bf16(asbf8(afr[1]), asbf8(kfr[1]), NakT, 0, 0, 0);
            f32x4 Mbr = __builtin_amdgcn_mfma_f32_16x16x32_bf16(asbf8(bfr[0]), asbf8(rfr[0]), z4, 0, 0, 0); Mbr = __builtin_amdgcn_mfma_f32_16x16x32_bf16(asbf8(bfr[1]), asbf8(rfr[1]), Mbr, 0, 0, 0);
            f32x4 Mkr = __builtin_amdgcn_mfma_f32_16x16x32_bf16(asbf8(kfr[0]), asbf8(rfr[0]), z4, 0, 0, 0); Mkr = __builtin_amdgcn_mfma_f32_16x16x32_bf16(asbf8(kfr[1]), asbf8(rfr[1]), Mkr, 0, 0, 0);
            f32x4 Idn;
#pragma unroll
            for (int q = 0; q < 4; ++q) { const unsigned row = (unsigned)(4 * kg + q);
                Nab[q] = row < cl ? Nab[q] : 0.f; NabT[q] = cl < row ? NabT[q] : 0.f; NakT[q] = cl < row ? NakT[q] : 0.f;
                Mbr[q] = row <= cl ? Mbr[q] : 0.f; Mkr[q] = row <= cl ? Mkr[q] : 0.f; Idn[q] = row == cl ? 1.f : 0.f; }
            f32x4 Tm = Idn + Nab;
            { const f32x4 P2 = prod16(NabT, Nab), P2T = prod16(Nab, NabT);
              Tm = Tm + prod16(P2T, Tm);
              const f32x4 P4 = prod16(P2T, P2), P4T = prod16(P2, P2T);
              Tm = Tm + prod16(P4T, Tm);
              const f32x4 P8T = prod16(P4, P4T);
              Tm = Tm + prod16(P8T, Tm); }
            const f32x4 NT = prod16(NakT, Tm);
            const unsigned lr = pk_lane_rows(lane);
            if (!dry) {
            wt16(pk_a1(A.ws, tile, h, 0), lr, afr[0]); wt16(pk_a1(A.ws, tile, h, 1), lr, afr[1]);
            wt16(pk_a1(A.ws, tile, h, 2), lr, rfr[0]); wt16(pk_a1(A.ws, tile, h, 3), lr, rfr[1]);
            { u32x4 w; w.x = pk2(Tm[0], Tm[1]); w.y = pk2(Tm[2], Tm[3]); w.z = pk2(NT[0], NT[1]); w.w = pk2(NT[2], NT[3]); wt16(sm, (unsigned)(lane * 16), w); }
            { u32x4 w; w.x = pk2(Mbr[0], Mbr[1]); w.y = pk2(Mbr[2], Mbr[3]); w.z = pk2(Mkr[0], Mkr[1]); w.w = pk2(Mkr[2], Mkr[3]); wt16(sm, (unsigned)(1024 + lane * 16), w); }
            LDS_WAIT();
#pragma unroll
            for (int jt = 0; jt < 4; ++jt) { const u32x2 lo = *(const LAS u32x2*)(TR + (16 * jt + tok) * 16 + 4 * kg), hi = *(const LAS u32x2*)(TR + 1024 + (16 * jt + tok) * 16 + 4 * kg);
                const u32x4 w4 = (u32x4){lo.x, lo.y, hi.x, hi.y};
                if (jt < 2) wt16(pk_a4lo(A.ws, tile, h, jt), lr, w4); else wt16(pk_a4hi((unsigned char*)A.out, tile, h, jt), (unsigned)(lane * 16), w4);
                { const u32x2 vq = *(const LAS u32x2*)(TR + 2048 + (16 * jt + tok) * 16 + 4 * kg); sto<u32x2>(sm, (unsigned)(2048 + jt * 512 + lane * 8), vq); } }
            } else asm volatile("" :: "v"(afr[0]), "v"(afr[1]), "v"(rfr[0]), "v"(rfr[1]), "v"(Tm), "v"(NT), "v"(Mbr), "v"(Mkr));
            LDS_WAIT();
        }
    }
    __syncthreads();
}

struct Pack { u32x4 a1[4], a2, a3, a4[4]; u32x2 vm; float gc; };
constexpr int RING = 14, SLOT = 11520, RING_FLAGS = RING * SLOT;
static_assert(RING_FLAGS + 64 <= 163840 - 256, "ring below the LDS control words");
__device__ __forceinline__ void glds16(const unsigned char* g, LAS unsigned char* d) { __builtin_amdgcn_global_load_lds((const unsigned*)g, (LAS unsigned*)d, 16, 0, 0); }
__device__ __forceinline__ void lds_pack_load(const LAS unsigned char* slot, unsigned va, unsigned vvm, unsigned vgc, Pack& P) {
#pragma unroll
    for (int f = 0; f < 4; ++f) { P.a1[f] = *(const LAS u32x4*)(slot + va + f * 1024); P.a4[f] = *(const LAS u32x4*)(slot + va + 4096 + f * 1024); }
    P.a2 = *(const LAS u32x4*)(slot + va + 8192); P.a3 = *(const LAS u32x4*)(slot + va + 9216);
    P.vm = *(const LAS u32x2*)(slot + vvm); P.gc = *(const LAS float*)(slot + vgc);
}
__device__ __forceinline__ void chunk_step(f32x4 (&H)[4], const Pack& P, __amdgpu_buffer_rsrc_t rs, unsigned vy, int sy, int dry = 0) {
    bf16x8 Hb[2];
#pragma unroll
    for (int ks = 0; ks < 2; ++ks) Hb[ks] = pack_bf8(H[2 * ks], H[2 * ks + 1]);
    const f32x4 z = (f32x4){0.f, 0.f, 0.f, 0.f};
    f32x4 XaT = __builtin_amdgcn_mfma_f32_16x16x32_bf16(asbf8(P.a1[0]), Hb[0], z, 0, 0, 0); XaT = __builtin_amdgcn_mfma_f32_16x16x32_bf16(asbf8(P.a1[1]), Hb[1], XaT, 0, 0, 0);
    f32x4 XrT = __builtin_amdgcn_mfma_f32_16x16x32_bf16(asbf8(P.a1[2]), Hb[0], z, 0, 0, 0); XrT = __builtin_amdgcn_mfma_f32_16x16x32_bf16(asbf8(P.a1[3]), Hb[1], XrT, 0, 0, 0);
    const u32x4 xv = (u32x4){pk2(XaT[0], XaT[1]), pk2(XaT[2], XaT[3]), P.vm.x, P.vm.y};
    const f32x4 SAT = __builtin_amdgcn_mfma_f32_16x16x32_bf16(asbf8(P.a2), asbf8(xv), z, 0, 0, 0);
    const u32x4 sv = (u32x4){pk2(SAT[0], SAT[1]), pk2(SAT[2], SAT[3]), P.vm.x, P.vm.y};
    const f32x4 YT = __builtin_amdgcn_mfma_f32_16x16x32_bf16(asbf8(P.a3), asbf8(sv), XrT, 0, 0, 0);
#pragma unroll
    for (int jt = 0; jt < 4; ++jt) { f32x4 hs;
        if (jt == 0) { hs[0] = nopack(H[0][0] * dppf<0x150, true>(P.gc)); hs[1] = nopack(H[0][1] * dppf<0x151, true>(P.gc)); hs[2] = nopack(H[0][2] * dppf<0x152, true>(P.gc)); hs[3] = nopack(H[0][3] * dppf<0x153, true>(P.gc)); }
        else if (jt == 1) { hs[0] = nopack(H[1][0] * dppf<0x154, true>(P.gc)); hs[1] = nopack(H[1][1] * dppf<0x155, true>(P.gc)); hs[2] = nopack(H[1][2] * dppf<0x156, true>(P.gc)); hs[3] = nopack(H[1][3] * dppf<0x157, true>(P.gc)); }
        else if (jt == 2) { hs[0] = nopack(H[2][0] * dppf<0x158, true>(P.gc)); hs[1] = nopack(H[2][1] * dppf<0x159, true>(P.gc)); hs[2] = nopack(H[2][2] * dppf<0x15A, true>(P.gc)); hs[3] = nopack(H[2][3] * dppf<0x15B, true>(P.gc)); }
        else { hs[0] = nopack(H[3][0] * dppf<0x15C, true>(P.gc)); hs[1] = nopack(H[3][1] * dppf<0x15D, true>(P.gc)); hs[2] = nopack(H[3][2] * dppf<0x15E, true>(P.gc)); hs[3] = nopack(H[3][3] * dppf<0x15F, true>(P.gc)); }
        H[jt] = __builtin_amdgcn_mfma_f32_16x16x32_bf16(asbf8(P.a4[jt]), asbf8(sv), hs, 0, 0, 0); }
    if (dry) { asm volatile("" :: "v"(YT)); return; }
#pragma unroll
    for (int r = 0; r < 4; ++r) __builtin_amdgcn_raw_buffer_store_b16((short)f2bf(YT[r]), rs, (int)vy + 1024 * r, sy, 0);
}
__device__ __forceinline__ void scan_chunk_block(const Args& A, int l, int bh, int qpair, int wv, LAS unsigned char* lds) {
    bh = opaque_s(bh); qpair = opaque_s(qpair);
    const int tid = opaque_tid(wv), lane = tid & 63;
    const int h = bh & 7, b = bh >> 3, tile0 = b * (SEQ / 16);
    volatile LAS unsigned* FL = (volatile LAS unsigned*)(lds + RING_FLAGS);
    constexpr int NCK = SEQ / 16;
    __syncthreads();
    if (tid < 18) FL[tid] = 0u;
    __syncthreads();
    if (wv >= 2) {
        const unsigned lr = pk_lane_rows(lane), l16 = (unsigned)lane * 16u, l4 = (unsigned)lane * 4u;
        auto issue = [&](int c) {
            if (c >= RING) { const unsigned need = (unsigned)(c - RING + 1); while (FL[16] < need || FL[17] < need) __builtin_amdgcn_s_sleep(2); }
            const int tile = tile0 + c; LAS unsigned char* slot = lds + (c % RING) * SLOT; unsigned char* ws = A.ws;
#pragma unroll
            for (int f = 0; f < 4; ++f) glds16(pk_a1(ws, tile, h, f) + lr, slot + f * 1024);
            glds16(pk_a4lo(ws, tile, h, 0) + lr, slot + 4096); glds16(pk_a4lo(ws, tile, h, 1) + lr, slot + 5120);
            glds16(pk_a4hi((unsigned char*)A.out, tile, h, 2) + l16, slot + 6144); glds16(pk_a4hi((unsigned char*)A.out, tile, h, 3) + l16, slot + 7168);
            const unsigned char* sm = pk_small(ws, tile, h);
            glds16(sm + l16, slot + 8192); glds16(sm + 1024 + l16, slot + 9216); glds16(sm + 2048 + qpair * 1024 + l16, slot + 10240);
            __builtin_amdgcn_global_load_lds((const unsigned*)(sm + 4096 + l4), (LAS unsigned*)(slot + 11264), 4, 0, 0); };
        issue(wv - 2);
        for (int c = wv - 2; c < NCK; c += 6) {
            if (c + 6 < NCK) { issue(c + 6); asm volatile("s_waitcnt vmcnt(12)" ::: "memory"); }
            else asm volatile("s_waitcnt vmcnt(0)" ::: "memory");
            FL[c % RING] = (unsigned)(c + 1);
        }
    } else {
        const int q = 2 * qpair + wv, ci = lane & 15, kg = lane >> 4;
        const __amdgpu_buffer_rsrc_t rs = __builtin_amdgcn_make_buffer_rsrc((void*)A.out, (short)0, (int)S17, 0x00020000);
        const unsigned va = (unsigned)lane * 16u, vvm = (unsigned)(10240 + wv * 512 + lane * 8), vgc = (unsigned)(11264 + (16 * ((lane & 15) >> 2) + 4 * kg + (lane & 3)) * 4), vy = (unsigned)(4 * kg * 512 + ci) * 2u;
        f32x4 H[4];
#pragma unroll
        for (int jt = 0; jt < 4; ++jt) H[jt] = (f32x4){0.f, 0.f, 0.f, 0.f};
        const int sy0 = (int)OS_Y + ((b * SEQ) * 512 + h * 64 + 16 * q) * 2;
        Pack P0, P1;
        while (FL[0] < 1u) __builtin_amdgcn_s_sleep(1);
        asm volatile("" ::: "memory");
        lds_pack_load(lds, va, vvm, vgc, P0);
        unsigned fnext = FL[1];
        int s1 = 1;
        for (int ch = 0; ch < NCK; ch += 2) {
            asm volatile("s_waitcnt lgkmcnt(0)" ::: "memory");
            FL[16 + wv] = (unsigned)(ch + 1);
            while (fnext < (unsigned)(ch + 2)) { __builtin_amdgcn_s_sleep(1); fnext = FL[s1]; }
            asm volatile("" ::: "memory");
            lds_pack_load(lds + s1 * SLOT, va, vvm, vgc, P1);
            s1 = s1 + 1 == RING ? 0 : s1 + 1;
            fnext = FL[s1];
            asm volatile("" ::: "memory");
            chunk_step(H, P0, rs, vy, sy0 + ch * 16384);
            asm volatile("s_waitcnt lgkmcnt(0)" ::: "memory");
            FL[16 + wv] = (unsigned)(ch + 2);
            if (ch + 2 < NCK) {
                while (fnext < (unsigned)(ch + 3)) { __builtin_amdgcn_s_sleep(1); fnext = FL[s1]; }
                asm volatile("" ::: "memory");
                lds_pack_load(lds + s1 * SLOT, va, vvm, vgc, P0);
                s1 = s1 + 1 == RING ? 0 : s1 + 1;
                fnext = FL[s1]; }
            asm volatile("" ::: "memory");
            chunk_step(H, P1, rs, vy, sy0 + (ch + 1) * 16384);
        }
        float* so = A.out + O_WKVP + ((((size_t)l * NB + b) * NH + h) * 64 + 16 * q + ci) * 64 + 4 * kg;
#pragma unroll
        for (int jt = 0; jt < 4; ++jt) *(f32x4*)(so + 16 * jt) = H[jt];
    }
}
__device__ __forceinline__ int ple_units_g2(int G) { const int fi = ((MT / 256) * (N2 / 256)) % G; return fi != 0 && 3 * (G - fi) >= 128 ? 128 : 0; }
template <int NCALL>
__device__ __forceinline__ void ple_units(CArgs Ap, int wv, LAS unsigned char* lds, int c, int stride, int half) {
    const Args A = load_args(Ap); c = opaque_s(c); stride = opaque_s(stride); half = opaque_s(half);
    pg8::Gemm g{(const bf16_t*)(A.ws + WS_PB) + (size_t)half * (MP / 2) * 256, (const bf16_t*)(A.ws + WS_WB + WB_PLE), MP / 2, 1024, 256};
    EpiMulAddS E{(bf16_t*)((unsigned char*)A.out + OS_PLE) + (size_t)half * (MP / 2) * 1024, nullptr, nullptr};
    { pg8::StaticOrder S; S.init(MP / 2, 1024, 1 << 20, c); pg8::gemm_phase<EpiMulAddS, pg8::StaticOrder, true, true>(lds, g, S, E, wv); }
    if (NCALL > 1) { pg8::StaticOrder S; S.init(MP / 2, 1024, 1 << 20, c + stride); pg8::gemm_phase<EpiMulAddS, pg8::StaticOrder, true, true>(lds, g, S, E, wv); }
    if (NCALL > 2) { pg8::StaticOrder S; S.init(MP / 2, 1024, 1 << 20, c + 2 * stride); pg8::gemm_phase<EpiMulAddS, pg8::StaticOrder, true, true>(lds, g, S, E, wv); }
}
__device__ __forceinline__ void ple_sample_rows(CArgs Ap, int wv, LAS unsigned char* lds, int c, int stride) {
    const Args A = load_args(Ap); c = opaque_s(c); stride = opaque_s(stride);
    const int tidm = opaque_tid(wv); bf16_t* O = (bf16_t*)((unsigned char*)A.out + OS_PLE);
    const bf16_t* Ap_ = (const bf16_t*)(A.ws + WS_PB); const bf16_t* Bp_ = (const bf16_t*)(A.ws + WS_WB + WB_PLE);
    for (int task = c; task < 128; task += stride)
        mini_gemm<256, 4>(Ap_, Bp_, lds, task, tidm, [=](int row, int col) { (void)row; (void)col; return 0; }, [=](int row, int col, f32x4 v, int) { const size_t off = (size_t)row * 1024 + col;
            u32x2 w; w.x = pk2(v[0], v[1]); w.y = pk2(v[2], v[3]); *(u32x2*)(O + off) = w; });
}
__device__ __forceinline__ void scan_phase(CArgs Ap, int wv, int l, LAS unsigned char* lds, int G, int mode = 0) {
    const Args A = load_args(Ap);
    ScanT T;
    T.R = (const bf16_t*)(A.ws + G_R); T.K = (const bf16_t*)(A.ws + G_K); T.V = (const bf16_t*)(A.ws + G_V); T.LORA = (const bf16_t*)(A.ws + G_LORA);
    T.VFIRST = l > 0 ? (const bf16_t*)(A.ws + WS_V0) : nullptr; T.VF = (bf16_t*)(A.ws + WS_V0);
    T.Y = (bf16_t*)A.out; T.RKP = (float*)(A.ws + WS_RKP);
    T.mu = A.in[8] + (size_t)l * NSHIFT; T.w0 = A.in[9] + l * 512; T.wup = A.in[10] + (size_t)l * 64 * 512; T.a0 = A.in[11] + l * 512; T.aup = A.in[12] + (size_t)l * 64 * 512;
    T.vup = l > 0 ? A.in[14] + (size_t)(l - 1) * 32 * 512 : nullptr; T.vb = l > 0 ? A.in[15] + (size_t)(l - 1) * 512 : nullptr;
    T.kk = A.in[16] + l * 512; T.ka = A.in[17] + l * 512; T.rk = A.in[18] + l * 512;
    T.sh0 = A.in[3] + (size_t)l * NS * NSHIFT;
    (void)mode;
    const int bx = opaque_s((int)blockIdx.x);
    if (G >= 2 * NB * NH + 64) {
        if (bx < 2 * NB * NH) { for (int r = 0; r < REP_CHUNK; ++r) scan_chunk_block(A, l, bx & (NB * NH - 1), bx >> 6, wv, lds); }
        else { const int NSB = G - 2 * NB * NH;
            for (int ig = bx - 2 * NB * NH; ig < (NS / 4) * NH; ig += NSB) scan_sample_group(A, T, l, ig, lds, wv);
            if (REP_SAMPLE_DRY) for (int ig = bx - 2 * NB * NH; ig < (NS / 4) * NH; ig += NSB) scan_sample_group(A, T, l, ig, lds, wv, 1); }
    } else {
        for (int ig = bx; ig < (NS / 4) * NH; ig += G) scan_sample_group(A, T, l, ig, lds, wv);
        for (int it = bx; it < 2 * NB * NH; it += G) scan_chunk_block(A, l, it & (NB * NH - 1), it >> 6, wv, lds);
    }
}

__device__ __forceinline__ void post_phase(CArgs Ap, int wv, int l, int G) {
    const Args A = load_args(Ap);
    const int tid = opaque_tid(wv); const int lane = tid & 63, wave = tid >> 6;
    const bf16_t* Y = (const bf16_t*)A.out; const bf16_t* VF = (const bf16_t*)(A.ws + WS_V0);
    const float* RKP = (const float*)(A.ws + WS_RKP); const bf16_t* GA = (const bf16_t*)(A.ws + G_GA); bf16_t* YA = (bf16_t*)(A.ws + G_R);
    const float* gg = A.in[19] + l * 512 + 8 * lane; const float* gb = A.in[20] + l * 512 + 8 * lane;
    const f32x4 g0 = *(const f32x4*)gg, g1 = *(const f32x4*)(gg + 4), b0 = *(const f32x4*)gb, b1 = *(const f32x4*)(gb + 4);
    constexpr int PR = 4;
    for (int m0 = blockIdx.x * 8 + wave; m0 < MR; m0 += PR * G * 8) {
        u32x4 ty[PR], tv[PR], tg[PR]; f32x2 rk2[PR];
#pragma unroll
        for (int b = 0; b < PR; ++b) { const int m = m0 + b * G * 8;
            if (m < MR) { ty[b] = *((const u32x4*)(Y + (size_t)m * 512) + lane); tv[b] = *((const u32x4*)(VF + (size_t)m * 512) + lane); tg[b] = *((const u32x4*)(GA + (size_t)m * 512) + lane);
                rk2[b] = *(const f32x2*)(RKP + (size_t)m * 16 + 2 * (lane >> 3)); }
            else { ty[b] = (u32x4){0u, 0u, 0u, 0u}; tv[b] = ty[b]; tg[b] = ty[b]; rk2[b] = (f32x2){0.f, 0.f}; } }
#pragma unroll
        for (int b = 0; b < PR; ++b) { const int m = m0 + b * G * 8;
            if (m < MR) {
                f32x4 y0, y1, v0, v1, ga0, ga1;
                unpack8(ty[b], y0, y1); unpack8(tv[b], v0, v1); unpack8(tg[b], ga0, ga1);
                const float rk = rk2[b].x + rk2[b].y;
                const float mean = rowsum8(((y0[0] + y0[1]) + (y0[2] + y0[3])) + ((y1[0] + y1[1]) + (y1[2] + y1[3]))) * (1.0f / 64.0f);
                y0 = y0 - mean; y1 = y1 - mean;
                const float var = rowsum8(dot4(y0, y0) + dot4(y1, y1)) * (1.0f / 64.0f);
                const float rstd = __builtin_amdgcn_rsqf(var + GN_EPS);
                const f32x4 o0 = (y0 * rstd * g0 + b0 + v0 * rk) * ga0, o1 = (y1 * rstd * g1 + b1 + v1 * rk) * ga1;
                wt16(YA, (unsigned)(((size_t)m * 512 + 8 * lane) * 2), pack8(o0, o1)); } }
    }
}

__device__ __forceinline__ void final_phase(CArgs Ap, int wv, int G) {
    const Args A = load_args(Ap);
    const int tid = opaque_tid(wv); const int lane = tid & 63, wave = tid >> 6;
    const float* ssq = (const float*)(A.ws + WS_SSQ); const float* fg = A.in[31]; const bf16_t* XB = (const bf16_t*)(A.ws + WS_XB);
    f32x4 g[4];
#pragma unroll
    for (int j = 0; j < 4; ++j) g[j] = *((const f32x4*)fg + lane + 64 * j);
    constexpr int FR = 4;
    for (int m0 = blockIdx.x * 8 + wave; m0 < MR; m0 += FR * G * 8) {
        u32x2 xv[FR][4]; float rs[FR];
#pragma unroll
        for (int b = 0; b < FR; ++b) { const int m = m0 + b * G * 8; rs[b] = 0.f;
#pragma unroll
            for (int j = 0; j < 4; ++j) xv[b][j] = (u32x2){0u, 0u};
            if (m < MR) { rs[b] = row_rstd(ssq, m); const u32x2* xr = (const u32x2*)(XB + (size_t)m * 1024) + lane;
#pragma unroll
                for (int j = 0; j < 4; ++j) xv[b][j] = xr[64 * j]; } }
#pragma unroll
        for (int b = 0; b < FR; ++b) { const int m = m0 + b * G * 8;
            if (m < MR) { f32x4* p = (f32x4*)(A.out + (size_t)m * 1024) + lane;
#pragma unroll
                for (int j = 0; j < 4; ++j) p[64 * j] = up4(xv[b][j]) * rs[b] * g[j]; } }
    }
}

#ifndef REP_SYNC
#define REP_SYNC 1
#endif
#ifndef REP_SCAN
#define REP_SCAN 1
#endif
#ifndef REP_SCAN_MODE
#define REP_SCAN_MODE 0
#endif
#ifndef REP_MIX_DRY
#define REP_MIX_DRY 0
#endif
#ifndef REP_OUT
#define REP_OUT 1
#endif
#ifndef REP_GATE
#define REP_GATE 1
#endif
#ifndef REP_MINI
#define REP_MINI 1
#endif
#ifndef REP_CONVERT
#define REP_CONVERT 1
#endif
#ifndef REP_BIG
#define REP_BIG 1
#endif
#ifndef REP_SMALL
#define REP_SMALL 1
#endif
#ifndef REP_P0
#define REP_P0 1
#endif
#ifndef REP_POST
#define REP_POST 1
#endif
#define GSYNC() do { for (int _r = 0; _r < REP_SYNC; ++_r) xcd_barrier(xbar, wv); } while (0)
constexpr int LDS_BYTES = 163840, MISC_OFF = 163840 - 256;
constexpr size_t CTL_ZERO_BYTES = 16 * KiB;
__global__ void __launch_bounds__(512, 2) fwd_kernel(Args A_unused) {
    extern __shared__ __attribute__((aligned(16))) unsigned char lds_raw[];
    LAS unsigned char* lds = (LAS unsigned char*)lds_raw;
    const int G = gridDim.x, bx = blockIdx.x, wv = __builtin_amdgcn_readfirstlane(threadIdx.x >> 6);
    const CArgs Ap = (CArgs)__builtin_amdgcn_kernarg_segment_ptr();
    volatile LAS unsigned* MISC = (volatile LAS unsigned*)(lds + MISC_OFF);
    if (threadIdx.x < 32) MISC[threadIdx.x] = 0u;
    __syncthreads();
    const XcdBarrier xbar = xcd_barrier_post((unsigned*)Ap->ws, MISC + 8);

    for (int r = 0; r < REP_P0; ++r) p0_prologue(Ap, wv, lds, G);
    GSYNC();

    for (int l = 0; l < DEPTH; ++l) {
        { const Args A = load_args(Ap); unsigned char* wb = A.ws + WS_WB; float* SSQ = (float*)(A.ws + WS_SSQ); bf16_t* XB = (bf16_t*)(A.ws + WS_XB); (void)SSQ; (void)XB;
          pg8::Gemm g{XB, (const bf16_t*)(wb + WB_W1), MP, N1, 1024}; pg8::StaticOrder S; S.init(MP, N1, G, opaque_s(bx));
          LAS float* RSL = (LAS float*)(lds + 131072); const int tidr = opaque_tid(wv);
          EpiG1 E{(bf16_t*)(A.ws + G_U), (bf16_t*)(A.ws + G_VB), (bf16_t*)(A.ws + G_GB), (bf16_t*)(A.ws + G_MB), (bf16_t*)(A.ws + G_GA), SSQ, (float*)(A.ws + WS_LNS), RSL};
          auto rstab = [=]() { if (tidr < 256) for (int i = 0; ; ++i) { Unit uu; if (!S.next(i, uu)) break; RSL[(uu.pm & 15) * 256 + tidr] = row_rstd(SSQ, uu.pm * 256 + tidr); } };
          for (int r = 0; r < REP_BIG; ++r) pg8::gemm_phase<EpiG1, pg8::StaticOrder, true, true>(lds, g, S, E, wv, rstab);
          const int tidm = opaque_tid(wv); bf16_t* pU = (bf16_t*)(A.ws + G_U); bf16_t* pVB = (bf16_t*)(A.ws + G_VB); bf16_t* pGB = (bf16_t*)(A.ws + G_GB); bf16_t* pMB = (bf16_t*)(A.ws + G_MB); bf16_t* pGA = (bf16_t*)(A.ws + G_GA); const float* ssqp = SSQ;
          for (int rm_ = 0; rm_ < REP_MINI; ++rm_) for (int task = opaque_s(bx); task < 8 * (N1 / 96); task += G)
              mini_gemm<1024, 6>(g.A, g.Bt, lds, task, tidm, [=](int row, int col) { (void)col; return row_rstd(ssqp, row); }, [=](int row, int col, f32x4 v, float rs) { v = v * rs;
                  bf16_t* o; if (col < 512) { for (int i = 0; i < 4; ++i) v[i] = gelu_tanh(v[i]); o = pU + (size_t)row * 512 + col; }
                  else if (col < 1024) { for (int i = 0; i < 4; ++i) v[i] = gelu_tanh(v[i]); o = pVB + (size_t)row * 512 + (col - 512); }
                  else if (col < 1536) { for (int i = 0; i < 4; ++i) v[i] = siluf_(v[i]); o = pGB + (size_t)row * 512 + (col - 1024); }
                  else if (col < 2560) { for (int i = 0; i < 4; ++i) v[i] = sigmoidf_(v[i]); o = pMB + (size_t)row * 1024 + (col - 1536); }
                  else { for (int i = 0; i < 4; ++i) v[i] = siluf_(v[i]); o = pGA + (size_t)row * 512 + (col - 2560); }
                  u32x2 w; w.x = pk2(v[0], v[1]); w.y = pk2(v[2], v[3]); *(u32x2*)o = w; }, N1 / 96);
          if (l == 0) {
              __syncthreads(); const int tidc = opaque_tid(wv), gw = opaque_s(bx) * 8 + wv, NGW = G * 8; LAS float* scr = (LAS float*)(lds + wv * 16384);
              for (int j = gw; j < 1792; j += NGW) p0_weight_item(A, 0, j < 896 ? 1280 + j : (j < 1408 ? 2432 + (j - 896) : (j < 1664 ? 3200 + (j - 1408) : 3968 + (j - 1664))), scr, tidc & 63);
              pb_convert(A, 0, gw, NGW, tidc & 63); }
          else {
              __syncthreads(); const int tidc = opaque_tid(wv), gw = opaque_s(bx) * 8 + wv, NGW = G * 8; LAS float* scr = (LAS float*)(lds + wv * 16384);
              for (int j = gw; j < 128; j += NGW) p0_weight_item(A, l, 3968 + j, scr, tidc & 63);
              pb_convert(A, l, gw, NGW, tidc & 63); } }
        GSYNC();
        mix_phase(Ap, wv, l, lds, G);
        if (REP_MIX_DRY) mix_phase(Ap, wv, l, lds, G, REP_MIX_DRY);
        GSYNC();
        { const Args A = load_args(Ap); unsigned char* wb = A.ws + WS_WB; float* SSQ = (float*)(A.ws + WS_SSQ); bf16_t* XB = (bf16_t*)(A.ws + WS_XB); (void)SSQ; (void)XB;
          pg8::Gemm g{(const bf16_t*)(A.ws + G_U), (const bf16_t*)(wb + WB_BB), MP, 1024, 512}; pg8::StaticOrder S; S.init(MP, 1024, G, opaque_s(bx));
          EpiMulAddS E{(bf16_t*)(A.ws + WS_BRB), (const bf16_t*)(A.ws + G_MB), nullptr};
          const int tidm = opaque_tid(wv); bf16_t* O = (bf16_t*)(A.ws + WS_BRB); const bf16_t* M1 = (const bf16_t*)(A.ws + G_MB);
          const int G_ = G, bx_ = opaque_s(bx);
          auto mini = [=]() { for (int rm_ = 0; rm_ < REP_MINI; ++rm_) for (int task = bx_; task < 128; task += G_)
              mini_gemm<512, 4>(g.A, g.Bt, lds + 131072, task, tidm, [=](int row, int col) { return *(const u32x2*)(M1 + (size_t)row * 1024 + col); }, [=](int row, int col, f32x4 v, u32x2 m1) { const size_t off = (size_t)row * 1024 + col; v = v * up4(m1);
                  u32x2 w; w.x = pk2(v[0], v[1]); w.y = pk2(v[2], v[3]); *(u32x2*)(O + off) = w; }); };
          for (int r = 0; r < REP_SMALL; ++r) pg8::gemm_phase<EpiMulAddS, pg8::StaticOrder, true, true>(lds, g, S, E, wv, mini);
          if (l + 1 < DEPTH) {
              __syncthreads(); const int tidc = opaque_tid(wv), gw = opaque_s(bx) * 8 + wv, NGW = G * 8; LAS float* scr = (LAS float*)(lds + wv * 16384);
              for (int j = gw; j < 2048; j += NGW) p0_weight_item(A, l + 1, j < 1280 ? j : (j < 1536 ? 2176 + (j - 1280) : 4096 + (j - 1536)), scr, tidc & 63); } }
        GSYNC();
        { const Args A = load_args(Ap); unsigned char* wb = A.ws + WS_WB; float* SSQ = (float*)(A.ws + WS_SSQ); bf16_t* XB = (bf16_t*)(A.ws + WS_XB); (void)SSQ; (void)XB;
          pg8::Gemm g{XB, (const bf16_t*)(wb + WB_W2), MT, N2, 1024}; pg8::StaticOrder S; S.init(MT, N2, G, opaque_s(bx));
          LAS float* RSL = (LAS float*)(lds + 131072); const int tidr = opaque_tid(wv);
          EpiG2 E{(bf16_t*)(A.ws + G_R), (bf16_t*)(A.ws + G_K), (bf16_t*)(A.ws + G_V), (bf16_t*)(A.ws + G_LORA), (bf16_t*)(A.ws + G_MA), SSQ,
                  A.out + O_SHP + (size_t)l * NB * NSHIFT, A.out + O_SHS + (size_t)l * NS * NSHIFT, (bf16_t*)(A.ws + WS_HALO), RSL};
          auto rstab = [=]() { if (tidr < 256) for (int i = 0; ; ++i) { Unit uu; if (!S.next(i, uu)) break; RSL[(uu.pm & 15) * 256 + tidr] = row_rstd(SSQ, uu.pm * 256 + tidr); } };
          for (int r = 0; r < REP_BIG; ++r) pg8::gemm_phase<EpiG2, pg8::StaticOrder, true, true>(lds, g, S, E, wv, rstab); }
        { const int first_idle = ((MT / 256) * (N2 / 256)) % G, bxc = opaque_s(bx);
          if (ple_units_g2(G) != 0 && bxc >= first_idle) { __syncthreads(); for (int rp_ = 0; rp_ < REP_PLE; ++rp_) ple_units<3>(Ap, wv, lds, bxc - first_idle, G - first_idle, 0); }
          {
              const bool split = ple_units_g2(G) != 0; const int nb = split ? first_idle : G, nit = l == 0 ? 1280 : 768;
              if (!split || bxc < first_idle) { __syncthreads(); const Args A = load_args(Ap); const int tidc = opaque_tid(wv); LAS float* scr = (LAS float*)(lds + wv * 16384);
                  for (int j = bxc * 8 + wv; j < nit; j += nb * 8) p0_weight_item(A, l, j < 256 ? 2944 + j : (j < 768 ? 3456 + (j - 256) : 4096 + (j - 768)), scr, tidc & 63); } } }
        GSYNC();
        prep_phase(Ap, wv, l, lds, G);
        if (REP_PREP_DRY) prep_phase(Ap, wv, l, lds, G, 1);
        GSYNC();
        for (int r = 0; r < REP_SCAN; ++r) scan_phase(Ap, wv, l, lds, G);
        { const int bxc = opaque_s(bx), nsb = G >= 2 * NB * NH + 64 ? G - 2 * NB * NH : G, cc = G >= 2 * NB * NH + 64 ? bxc - 2 * NB * NH : bxc;
          if (cc >= 0) for (int rp_ = 0; rp_ < REP_PLE; ++rp_) { __syncthreads(); if (ple_units_g2(G)) ple_units<2>(Ap, wv, lds, cc, nsb, 1); else { ple_units<3>(Ap, wv, lds, cc, nsb, 0); ple_units<3>(Ap, wv, lds, cc, nsb, 1); } __syncthreads(); ple_sample_rows(Ap, wv, lds, cc, nsb); } }
        GSYNC();
        for (int r = 0; r < REP_POST; ++r) post_phase(Ap, wv, l, G);
        GSYNC();
        { const Args A = load_args(Ap); unsigned char* wb = A.ws + WS_WB; float* SSQ = (float*)(A.ws + WS_SSQ); bf16_t* XB = (bf16_t*)(A.ws + WS_XB); (void)SSQ; (void)XB;
          pg8::Gemm g{(const bf16_t*)(A.ws + G_R), (const bf16_t*)(wb + WB_BA), MP, 1024, 512}; pg8::StaticOrder S; S.init(MP, 1024, G, opaque_s(bx));
          EpiMulAddS E{(bf16_t*)(A.ws + G_K), (const bf16_t*)(A.ws + G_MA), (const bf16_t*)(A.ws + WS_BRB)};
          const int tidm = opaque_tid(wv); bf16_t* O = (bf16_t*)(A.ws + G_K); const bf16_t* M1 = (const bf16_t*)(A.ws + G_MA); const bf16_t* AD = (const bf16_t*)(A.ws + WS_BRB);
          const int G_ = G, bx_ = opaque_s(bx);
          auto mini = [=]() {
          for (int rm_ = 0; rm_ < REP_MINI; ++rm_) for (int task = bx_; task < 128; task += G_)
              mini_gemm<512, 4>(g.A, g.Bt, lds + 131072, task, tidm, [=](int row, int col) { const size_t off = (size_t)row * 1024 + col; const u32x2 a = *(const u32x2*)(M1 + off), b = *(const u32x2*)(AD + off); return (u32x4){a.x, a.y, b.x, b.y}; },
                  [=](int row, int col, f32x4 v, u32x4 pr) { const size_t off = (size_t)row * 1024 + col; v = v * up4((u32x2){pr.x, pr.y}) + up4((u32x2){pr.z, pr.w});
                  u32x2 w; w.x = pk2(v[0], v[1]); w.y = pk2(v[2], v[3]); *(u32x2*)(O + off) = w; }); };
          for (int r = 0; r < REP_SMALL; ++r) pg8::gemm_phase<EpiMulAddS, pg8::StaticOrder, true, true>(lds, g, S, E, wv, mini);
          if (l + 1 < DEPTH) {
              __syncthreads(); const int tidc = opaque_tid(wv), gw = opaque_s(bx) * 8 + wv, NGW = G * 8; LAS float* scr = (LAS float*)(lds + wv * 16384);
              for (int j = gw; j < 1664; j += NGW) p0_weight_item(A, l + 1, j < 896 ? 1280 + j : (j < 1408 ? 2432 + (j - 896) : 3200 + (j - 1408)), scr, tidc & 63); } }
        GSYNC();
        { const Args A = load_args(Ap); unsigned char* wb = A.ws + WS_WB; float* SSQ = (float*)(A.ws + WS_SSQ); bf16_t* XB = (bf16_t*)(A.ws + WS_XB); (void)SSQ; (void)XB;
          pg8::Gemm g{(const bf16_t*)(A.ws + G_K), (const bf16_t*)(wb + WB_OUT), MP, 1024, 1024}; pg8::StaticOrder S; S.init(MP, 1024, G, opaque_s(bx));
          EpiOutS E{XB, (bf16_t*)(A.ws + WS_BRB)};
          const int tidm = opaque_tid(wv); bf16_t* H1B = (bf16_t*)(A.ws + WS_BRB); const bf16_t* hin = XB;
          const int G_ = G, bx_ = opaque_s(bx);
          auto mini = [=]() {
          for (int rm_ = 0; rm_ < REP_MINI; ++rm_) for (int task = bx_; task < 128; task += G_)
              mini_gemm<1024, 4>(g.A, g.Bt, lds + 131072, task, tidm, [=](int row, int col) { return *(const u32x2*)(hin + (size_t)row * 1024 + col); }, [=](int row, int col, f32x4 v, u32x2 hv) { const size_t off = (size_t)row * 1024 + col; v = v + up4(hv);
                  u32x2 w; w.x = pk2(v[0], v[1]); w.y = pk2(v[2], v[3]); *(u32x2*)(H1B + off) = w; }); };
          for (int r = 0; r < REP_OUT; ++r) pg8::gemm_phase<EpiOutS, pg8::StaticOrder, true, true>(lds, g, S, E, wv, mini); }
        GSYNC();
        { const Args A = load_args(Ap); unsigned char* wb = A.ws + WS_WB; float* SSQ = (float*)(A.ws + WS_SSQ); bf16_t* XB = (bf16_t*)(A.ws + WS_XB); (void)SSQ; (void)XB;
          pg8::Gemm g{(const bf16_t*)(A.ws + WS_BRB), (const bf16_t*)(wb + ((l & 1) ? WB_GATE_ALT : WB_GATE)), MP, 1024, 1024}; pg8::StaticOrder S; S.init(MP, 1024, G, opaque_s(bx));
          EpiGateS E{(const bf16_t*)(A.ws + WS_BRB), (const bf16_t*)((unsigned char*)A.out + OS_PLE), A.in[30] + l * 1024, XB, SSQ};
          const int tidm = opaque_tid(wv); const bf16_t* H1B = (const bf16_t*)(A.ws + WS_BRB); const bf16_t* PLE = (const bf16_t*)((unsigned char*)A.out + OS_PLE); const float* bias = A.in[30] + l * 1024; bf16_t* XBo = XB; float* ssq = SSQ;
          const int G_ = G, bx_ = opaque_s(bx);
          auto mini = [=]() {
          for (int rm_ = 0; rm_ < REP_MINI; ++rm_) for (int task = bx_; task < 128; task += G_)
              mini_gemm<1024, 4>(g.A, g.Bt, lds + 131072, task, tidm, [=](int row, int col) { const size_t off = (size_t)row * 1024 + col; const u32x2 a = *(const u32x2*)(H1B + off), b = *(const u32x2*)(PLE + off); return (u32x4){a.x, a.y, b.x, b.y}; },
                  [=](int row, int col, f32x4 v, u32x4 pr) { const size_t off = (size_t)row * 1024 + col;
                  f32x4 h = up4((u32x2){pr.x, pr.y}); const f32x4 p = up4((u32x2){pr.z, pr.w}), a = v + *(const f32x4*)(bias + col);
                  h[0] += sigmoidf_(a[0]) * p[0]; h[1] += sigmoidf_(a[1]) * p[1]; h[2] += sigmoidf_(a[2]) * p[2]; h[3] += sigmoidf_(a[3]) * p[3];
                  u32x2 w; w.x = pk2(h[0], h[1]); w.y = pk2(h[2], h[3]); *(u32x2*)(XBo + off) = w;
                  const float ss = xrow_sum((h[0] * h[0] + h[1] * h[1]) + (h[2] * h[2] + h[3] * h[3]));
                  if ((col & 15) == 0) ssq[(size_t)MT * 16 + (size_t)(row - MP) * 64 + (col >> 4)] = ss; }); };
          for (int r = 0; r < REP_GATE; ++r) pg8::gemm_phase<EpiGateS, pg8::StaticOrder, true, true>(lds, g, S, E, wv, mini);
        }
        GSYNC();
    }
    final_phase(Ap, wv, G);
}

extern "C" void kernel_launch(void* const* d_in, const int* in_sizes, int n_in, void* d_out, int out_size, void* d_ws, size_t ws_size, hipStream_t stream) {
    static int grid = 0;
    if (grid == 0) {
        int dev = 0, cus = 0, per_cu = 0;
        hipGetDevice(&dev);
        hipDeviceGetAttribute(&cus, hipDeviceAttributeMultiprocessorCount, dev);
        hipFuncSetAttribute((const void*)fwd_kernel, hipFuncAttributeMaxDynamicSharedMemorySize, LDS_BYTES);
        hipOccupancyMaxActiveBlocksPerMultiprocessor(&per_cu, (const void*)fwd_kernel, 512, LDS_BYTES);
        if (per_cu < 1) { fprintf(stderr, "kernel_launch: occupancy query says %d blocks per CU\n", per_cu); per_cu = 1; }
        grid = cus;
        if (ws_size < WS_END) { fprintf(stderr, "kernel_launch: workspace too small: %zu < %zu\n", ws_size, (size_t)WS_END); grid = -1; }
        (void)hipGetLastError();
    }
    if (grid < 0) return;
    if (hipMemsetAsync(d_ws, 0, CTL_ZERO_BYTES, stream) != hipSuccess) { fprintf(stderr, "kernel_launch: memset failed\n"); return; }
    Args a{};
    for (int i = 0; i < 32; ++i) a.in[i] = (const float*)d_in[i];
    a.out = (float*)d_out; a.ws = (unsigned char*)d_ws;
    void* args[] = {&a};
    hipError_t e = hipLaunchCooperativeKernel((const void*)fwd_kernel, dim3(grid), dim3(512), args, LDS_BYTES, stream);
    if (e != hipSuccess) fprintf(stderr, "cooperative launch failed: %s (grid %d)\n", hipGetErrorString(e), grid);
}
```
